# Optimizing an MI355X kernel written in HIP

```python
import math
import jax, jax.numpy as jnp
from jax import lax
import numpy as np

D_MODEL = 1024
BATCH = 2
SEQ = 8192
DEPTH = 2

HEAD_DIM = 64
H_MLA = 8
H_MOBA = 8
MLA_WIDTH = H_MLA * HEAD_DIM
MOBA_WIDTH = H_MOBA * HEAD_DIM
D_MIX = MLA_WIDTH + MOBA_WIDTH
Q_LORA = 256
KV_LORA = 128
NOPE_DIM = 64
ROPE_DIM = 32
V_DIM = HEAD_DIM
QK_DIM = NOPE_DIM + ROPE_DIM
ROPE_THETA = 10000.0
MOBA_BLOCK = 256
MOBA_TOPK = 3
Q_BLOCK = 128
MOBA_Q_CHUNK = 64
N_BUCKETS = 32
REL_MAX_DIST = 4096
EPS = 1e-6

IN_SPLITS = (Q_LORA, KV_LORA, ROPE_DIM, MLA_WIDTH, MOBA_WIDTH, MOBA_WIDTH, MOBA_WIDTH, MOBA_WIDTH)
IN_OFFSETS = (Q_LORA,
              Q_LORA + KV_LORA,
              Q_LORA + KV_LORA + ROPE_DIM,
              Q_LORA + KV_LORA + ROPE_DIM + MLA_WIDTH,
              Q_LORA + KV_LORA + ROPE_DIM + MLA_WIDTH + MOBA_WIDTH,
              Q_LORA + KV_LORA + ROPE_DIM + MLA_WIDTH + 2 * MOBA_WIDTH,
              Q_LORA + KV_LORA + ROPE_DIM + MLA_WIDTH + 3 * MOBA_WIDTH)
D_IN = Q_LORA + KV_LORA + ROPE_DIM + MLA_WIDTH + 4 * MOBA_WIDTH

kernel_name = "hybrid_mla_moba_adaln_block"


def rms_norm(x, g):
    xf = x.astype(jnp.float32)
    y = xf * lax.rsqrt(jnp.mean(xf * xf, axis=-1, keepdims=True) + EPS)
    return (y * g.astype(jnp.float32)).astype(x.dtype)


def apply_rope(x, positions):
    half = ROPE_DIM // 2
    inv_freq = ROPE_THETA ** (-jnp.arange(0, half, dtype=jnp.float32) / half)
    ang = positions.astype(jnp.float32)[..., None] * inv_freq
    cos = jnp.cos(ang)[:, :, None, :]
    sin = jnp.sin(ang)[:, :, None, :]
    xf = x.astype(jnp.float32)
    x1, x2 = xf[..., :half], xf[..., half:]
    out = jnp.concatenate([x1 * cos - x2 * sin, x1 * sin + x2 * cos], axis=-1)
    return out.astype(x.dtype)


def rel_bucket(dist):
    n = jnp.maximum(dist, 0)
    max_exact = N_BUCKETS // 2
    nf = jnp.maximum(n, 1).astype(jnp.float32)
    large = max_exact + (jnp.log(nf / max_exact) / math.log(REL_MAX_DIST / max_exact)
                         * (N_BUCKETS - max_exact)).astype(jnp.int32)
    large = jnp.minimum(large, N_BUCKETS - 1)
    return jnp.where(n < max_exact, n, large)


def mla_attention(c_q, c_kv, k_rope, positions, q_norm_g, w_uq, kv_norm_g, w_ukv, q_g, k_g):
    B, S, _ = c_q.shape
    q = (rms_norm(c_q, q_norm_g) @ w_uq).reshape(B, S, H_MLA, QK_DIM)
    kv = (rms_norm(c_kv, kv_norm_g) @ w_ukv).reshape(B, S, H_MLA, NOPE_DIM + V_DIM)
    k_nope, v = kv[..., :NOPE_DIM], kv[..., NOPE_DIM:]
    k = jnp.concatenate(
        [k_nope, jnp.broadcast_to(k_rope[:, :, None, :], (B, S, H_MLA, ROPE_DIM))], axis=-1)
    q = rms_norm(q, q_g)
    k = rms_norm(k, k_g)
    q = jnp.concatenate([q[..., :NOPE_DIM], apply_rope(q[..., NOPE_DIM:], positions)], axis=-1)
    k = jnp.concatenate([k[..., :NOPE_DIM], apply_rope(k[..., NOPE_DIM:], positions)], axis=-1)
    n_qb = S // Q_BLOCK
    qb = q.reshape(B, n_qb, Q_BLOCK, H_MLA, QK_DIM).transpose(1, 0, 2, 3, 4)
    kpos = jnp.arange(S)
    scale = QK_DIM ** -0.5

    def block(args):
        q_blk, i = args
        s = jnp.einsum('bqhd,bkhd->bhqk', q_blk, k,
                       preferred_element_type=jnp.float32) * scale
        qpos = i * Q_BLOCK + jnp.arange(Q_BLOCK)
        s = jnp.where(kpos[None, :] <= qpos[:, None], s, -jnp.inf)
        p = jax.nn.softmax(s, axis=-1)
        return jnp.einsum('bhqk,bkhd->bqhd', p.astype(v.dtype), v)

    o = lax.map(block, (qb, jnp.arange(n_qb)))
    return o.transpose(1, 0, 2, 3, 4).reshape(B, S, MLA_WIDTH)


def moba_attention(q, k, v, q_g, k_g, rel_bias):
    B, S, _ = q.shape
    q = rms_norm(q.reshape(B, S, H_MOBA, HEAD_DIM), q_g).transpose(0, 2, 1, 3)
    k = rms_norm(k.reshape(B, S, H_MOBA, HEAD_DIM), k_g).transpose(0, 2, 1, 3)
    v = v.reshape(B, S, H_MOBA, HEAD_DIM).transpose(0, 2, 1, 3)
    nb = -(-S // MOBA_BLOCK)
    pad = nb * MOBA_BLOCK - S
    kp = jnp.pad(k, ((0, 0), (0, 0), (0, pad), (0, 0))).reshape(B, H_MOBA, nb, MOBA_BLOCK, HEAD_DIM)
    vp = jnp.pad(v, ((0, 0), (0, 0), (0, pad), (0, 0))).reshape(B, H_MOBA, nb, MOBA_BLOCK, HEAD_DIM)
    blk_ids = jnp.arange(nb)
    counts = jnp.minimum(S - blk_ids * MOBA_BLOCK, MOBA_BLOCK).astype(jnp.float32)
    k_mean = kp.astype(jnp.float32).sum(axis=3) / counts[None, None, :, None]
    topk = min(MOBA_TOPK, nb)
    n_qc = S // MOBA_Q_CHUNK
    qc = q.reshape(B, H_MOBA, n_qc, MOBA_Q_CHUNK, HEAD_DIM).transpose(2, 0, 1, 3, 4)
    scale = HEAD_DIM ** -0.5
    bias_t = rel_bias.astype(jnp.float32).T
    head_idx = jnp.arange(H_MOBA)[None, :, None, None, None]
    gather_blocks = jax.vmap(jax.vmap(lambda blocks, idx: blocks[idx]))

    def chunk(args):
        q_c, i = args
        q0 = i * MOBA_Q_CHUNK
        own = q0 // MOBA_BLOCK
        qpos = q0 + jnp.arange(MOBA_Q_CHUNK)
        g = jnp.einsum('bhqd,bhnd->bhqn', q_c.astype(jnp.float32), k_mean)
        g = jnp.where(blk_ids < own, g, -jnp.inf)
        _, sel = lax.top_k(g, topk)
        valid = (jnp.arange(topk) < own)[:, None]
        k_sel = gather_blocks(kp, sel)
        v_sel = gather_blocks(vp, sel)
        s_sel = jnp.einsum('bhqd,bhqtkd->bhqtk', q_c, k_sel,
                           preferred_element_type=jnp.float32) * scale
        kpos_sel = sel[..., None] * MOBA_BLOCK + jnp.arange(MOBA_BLOCK)
        bias_sel = bias_t[head_idx, rel_bucket(qpos[:, None, None] - kpos_sel)]
        s_sel = jnp.where(valid, s_sel + bias_sel, -jnp.inf)
        k_own = lax.dynamic_slice_in_dim(kp, own, 1, axis=2)[:, :, 0]
        v_own = lax.dynamic_slice_in_dim(vp, own, 1, axis=2)[:, :, 0]
        s_own = jnp.einsum('bhqd,bhkd->bhqk', q_c, k_own,
                           preferred_element_type=jnp.float32) * scale
        kpos_own = own * MOBA_BLOCK + jnp.arange(MOBA_BLOCK)
        dist_own = qpos[:, None] - kpos_own[None, :]
        bias_own = bias_t[:, rel_bucket(dist_own)]
        s_own = jnp.where(dist_own >= 0, s_own + bias_own[None], -jnp.inf)
        s_all = jnp.concatenate(
            [s_sel.reshape(B, H_MOBA, MOBA_Q_CHUNK, topk * MOBA_BLOCK), s_own], axis=-1)
        p = jax.nn.softmax(s_all, axis=-1).astype(v.dtype)
        p_sel = p[..., :topk * MOBA_BLOCK].reshape(B, H_MOBA, MOBA_Q_CHUNK, topk, MOBA_BLOCK)
        p_own = p[..., topk * MOBA_BLOCK:]
        return (jnp.einsum('bhqtk,bhqtkd->bhqd', p_sel, v_sel)
                + jnp.einsum('bhqk,bhkd->bhqd', p_own, v_own))

    o = lax.map(chunk, (qc, jnp.arange(n_qc)))
    o = o.transpose(1, 2, 0, 3, 4).reshape(B, H_MOBA, S, HEAD_DIM)
    return o.transpose(0, 2, 1, 3).reshape(B, S, MOBA_WIDTH)


def hybrid_layer(x, c, positions, norm_g, w_ada, b_ada, w_in, mla_q_norm_g, mla_w_uq,
                 mla_kv_norm_g, mla_w_ukv, mla_q_g, mla_k_g, moba_q_g, moba_k_g, w_out, rel_bias):
    mod = jax.nn.silu(c) @ w_ada + b_ada
    shift, scale, gate = jnp.split(mod[:, None, :], 3, axis=-1)
    h = rms_norm(x, norm_g) * (1 + scale) + shift
    z = h @ w_in
    c_q, c_kv, k_rope, g_mla, q_b, k_b, v_b, g_moba = jnp.split(z, list(IN_OFFSETS), axis=-1)
    o_mla = mla_attention(c_q, c_kv, k_rope, positions, mla_q_norm_g, mla_w_uq,
                          mla_kv_norm_g, mla_w_ukv, mla_q_g, mla_k_g)
    o_moba = moba_attention(q_b, k_b, v_b, moba_q_g, moba_k_g, rel_bias)
    y = jnp.concatenate([jax.nn.silu(g_mla) * o_mla, jax.nn.silu(g_moba) * o_moba], axis=-1) @ w_out
    return x + gate * y


def setup_inputs(seed: int = 0) -> dict:
    key = jax.random.key(seed)
    ks = jax.random.split(key, 20)
    f32 = jnp.float32
    nrm = lambda k, shape, s: jax.random.normal(k, shape, f32) * s
    return {
        "x": nrm(ks[0], (BATCH, SEQ, D_MODEL), 1.0),
        "c": nrm(ks[1], (BATCH, D_MODEL), 1.0),
        "positions": jnp.broadcast_to(jnp.arange(SEQ, dtype=jnp.int32), (BATCH, SEQ)),
        "norm_g": 1.0 + nrm(ks[2], (DEPTH, D_MODEL), 0.05),
        "w_ada": nrm(ks[3], (DEPTH, D_MODEL, 3 * D_MODEL), 0.5 * D_MODEL ** -0.5),
        "b_ada": nrm(ks[4], (DEPTH, 3 * D_MODEL), 0.01),
        "w_in": nrm(ks[5], (DEPTH, D_MODEL, D_IN), D_MODEL ** -0.5),
        "mla_q_norm_g": 1.0 + nrm(ks[6], (DEPTH, Q_LORA), 0.05),
        "mla_w_uq": nrm(ks[7], (DEPTH, Q_LORA, H_MLA * QK_DIM), Q_LORA ** -0.5),
        "mla_kv_norm_g": 1.0 + nrm(ks[8], (DEPTH, KV_LORA), 0.05),
        "mla_w_ukv": nrm(ks[9], (DEPTH, KV_LORA, H_MLA * (NOPE_DIM + V_DIM)), KV_LORA ** -0.5),
        "mla_q_g": 1.0 + nrm(ks[10], (DEPTH, QK_DIM), 0.05),
        "mla_k_g": 1.0 + nrm(ks[11], (DEPTH, QK_DIM), 0.05),
        "moba_q_g": 1.0 + nrm(ks[12], (DEPTH, HEAD_DIM), 0.05),
        "moba_k_g": 1.0 + nrm(ks[13], (DEPTH, HEAD_DIM), 0.05),
        "w_out": nrm(ks[14], (DEPTH, D_MIX, D_MODEL), D_MIX ** -0.5),
        "rel_bias": nrm(ks[15], (N_BUCKETS, H_MOBA), 0.5),
    }


def reference(x, c, positions, norm_g, w_ada, b_ada, w_in, mla_q_norm_g, mla_w_uq,
              mla_kv_norm_g, mla_w_ukv, mla_q_g, mla_k_g, moba_q_g, moba_k_g, w_out, rel_bias):
    for l in range(DEPTH):
        x = hybrid_layer(x, c, positions, norm_g[l], w_ada[l], b_ada[l], w_in[l],
                         mla_q_norm_g[l], mla_w_uq[l], mla_kv_norm_g[l], mla_w_ukv[l],
                         mla_q_g[l], mla_k_g[l], moba_q_g[l], moba_k_g[l], w_out[l], rel_bias)
    return x
```

```cpp
#include <hip/hip_runtime.h>
#include <hip/hip_bf16.h>
#include <cstdio>
#include <cstdint>
#include <cmath>

#ifndef MK_ONE_LAUNCH
#define MK_ONE_LAUNCH 1
#endif

#define LAS __attribute__((address_space(3)))
#define GAS __attribute__((address_space(1)))
typedef unsigned short bf16_t;
typedef short bf16x8 __attribute__((ext_vector_type(8)));
typedef short s16x4 __attribute__((ext_vector_type(4)));
typedef float f32x4 __attribute__((ext_vector_type(4)));
typedef float f32x2 __attribute__((ext_vector_type(2)));
typedef float f32x16 __attribute__((ext_vector_type(16)));
typedef unsigned u32x4 __attribute__((ext_vector_type(4)));
typedef unsigned u32x2 __attribute__((ext_vector_type(2)));

constexpr int BATCH = 2, SEQ = 8192, DMODEL = 1024, DEPTH = 2;
constexpr int M = BATCH * SEQ;
constexpr int D_IN = 2976, ZP = 3072;
constexpr int ZC_CQ = 0, ZC_CKV = 256, ZC_KROPE = 384, ZC_GMLA = 512, ZC_QB = 1024, ZC_KB = 1536, ZC_VB = 2048, ZC_GMOBA = 2560;
constexpr int QLORA = 256, KVLORA = 128, NQ = 768, NKV = 1024;
constexpr float EPS = 1e-6f;
constexpr float LOG2E = 1.4426950408889634f;
constexpr float QSCALE_A = 0.10206207261596577f * LOG2E;
constexpr float QSCALE_B = 0.125f * LOG2E;

constexpr size_t MiB = 1u << 20;
constexpr size_t WS_CTL = 0, CTL_ZERO_BYTES = 1 * MiB;
constexpr size_t WS_W = 2 * MiB, W_LAYER = 10 * MiB;
constexpr size_t W_IN = 0, W_OUT = 6 * MiB, W_UQ = 8 * MiB, W_UKV = 9 * MiB;
constexpr size_t WS_MOD = 22 * MiB;
constexpr size_t WS_BIAS = 22 * MiB + 64 * 1024;
constexpr size_t WS_KPART = 22 * MiB + 512 * 1024;
constexpr size_t WS_ROPE = 24 * MiB;
constexpr size_t WS_H = 26 * MiB;
constexpr size_t WS_Z = 58 * MiB;
constexpr size_t WS_Q = 154 * MiB;
constexpr size_t WS_KV = 178 * MiB;
constexpr size_t WS_K = 210 * MiB;
constexpr size_t WS_KF = WS_H, WS_VF = WS_H + 16 * MiB;
constexpr size_t WS_END = 234 * MiB;
constexpr int CW_BAR = 4096, CW_Q = 16384;
constexpr int ZC_AO = 1536;

__device__ __forceinline__ unsigned f2bf(float f) { unsigned u = __builtin_bit_cast(unsigned, f); return (u + 0x7fffu + ((u >> 16) & 1u)) >> 16; }
__device__ __forceinline__ unsigned pk2(float lo, float hi) { typedef __bf16 bf16x2_t __attribute__((ext_vector_type(2))); f32x2 v = {lo, hi}; return __builtin_bit_cast(unsigned, __builtin_convertvector(v, bf16x2_t)); }
__device__ __forceinline__ float bflo(unsigned w) { return __builtin_bit_cast(float, w << 16); }
__device__ __forceinline__ float bfhi(unsigned w) { return __builtin_bit_cast(float, w & 0xffff0000u); }
template <int X> __device__ __forceinline__ float swz_xor(float v) { return __builtin_bit_cast(float, __builtin_amdgcn_ds_swizzle(__builtin_bit_cast(int, v), (X << 10) | 0x1f)); }
__device__ __forceinline__ float swz_xor_dyn(float v, int x) {
    switch (x) { case 1: return swz_xor<1>(v); case 2: return swz_xor<2>(v); case 4: return swz_xor<4>(v); case 8: return swz_xor<8>(v); default: return swz_xor<16>(v); } }
__device__ __forceinline__ float sum8(float v) { v += swz_xor<1>(v); v += swz_xor<2>(v); v += swz_xor<4>(v); return v; }
__device__ __forceinline__ float wave_sum(float v) {
    v = sum8(v); v += swz_xor<8>(v); v += swz_xor<16>(v);
    auto rr = __builtin_amdgcn_permlane32_swap(__builtin_bit_cast(unsigned, v), __builtin_bit_cast(unsigned, v), false, false);
    return __builtin_bit_cast(float, rr[0]) + __builtin_bit_cast(float, rr[1]);
}
__device__ __forceinline__ const void* launder_s(const void* p) { asm volatile("" : "+s"(p)); return p; }
constexpr unsigned WTAB_LDS = 143360 + 320 + 128;
__device__ __forceinline__ int hw_slot() { return (int)(__builtin_amdgcn_s_getreg((5 << 11) | 4) & 63u); }
__device__ __forceinline__ int tidx() {
    const unsigned w = ((volatile LAS unsigned*)(size_t)WTAB_LDS)[hw_slot()];
    int lane_; asm volatile("v_mbcnt_lo_u32_b32 %0, -1, 0\n\tv_mbcnt_hi_u32_b32 %0, -1, %0" : "=v"(lane_));
    return (int)((unsigned)__builtin_amdgcn_readfirstlane((int)w) << 6) | lane_;
}
template <class V> __device__ __forceinline__ void store16_wt(void* p, V v) { static_assert(sizeof(V) == 16, "16-byte payload");
    asm volatile("global_store_dwordx4 %0, %1, off sc1\n\ts_nop 1" :: "v"(p), "v"(v) : "memory"); }
__device__ __forceinline__ int launder_s32(int v) { asm volatile("" : "+s"(v)); return v; }
__device__ __forceinline__ int launder(int v) { asm volatile("" : "+v"(v)); return v; }
#define LDS_WAIT() asm volatile("s_waitcnt lgkmcnt(0)" ::: "memory")
#define VM_WAIT() asm volatile("s_waitcnt vmcnt(0)" ::: "memory")

namespace pg8 {
constexpr int BM = 256, BK = 64, HALF = 128, HTB = HALF * BK * 2, STAGE_BYTES = 8 * HTB, NXCD = 8, WGM = 8;
__host__ __device__ __forceinline__ int lds_byte(int r, int c) { const int st = (r >> 4) * 2 + (c >> 5), rr = r & 15, cc = c & 31, ob = rr * 64 + cc * 2; return st * 1024 + (ob ^ (((ob >> 9) & 1) << 5)); }
__host__ __device__ __forceinline__ void stage_rc(int b, int& R, int& C) { const int st = b / 1024, sb = b % 1024, swz = sb ^ (((sb >> 9) & 1) << 5); R = (st >> 1) * 16 + swz / 64; C = (st & 1) * 32 + (swz % 64) / 2; }
__host__ __device__ __forceinline__ int perm32(int rho) { const int n = rho >> 4, i = rho & 15; return 8 * (i >> 2) + 4 * n + (i & 3); }
struct Unit { int pm, pn; };
struct Gemm { const bf16_t* A; const bf16_t* Bt; int M, N, K, lda, ldb; };
struct StaticOrder {
    int nM, nN, nwg, G, c;
    __device__ void init(int M_, int N_, int G_, int c_) { nM = M_ / BM; nN = N_ / BM; nwg = nM * nN; G = G_; c = c_; }
    __device__ bool next(int i, Unit& u) const {
        const long L = (long)i * G + c; if (L >= nwg) return false;
        int wgid = (int)L; { const int q = nwg / NXCD, r = nwg % NXCD, xcd = wgid % NXCD, off = wgid / NXCD; wgid = (xcd < r ? xcd * (q + 1) : r * (q + 1) + (xcd - r) * q) + off; }
        const int nig = WGM * nN, gid = wgid / nig, fm = gid * WGM, gsz = (nM - fm) < WGM ? (nM - fm) : WGM;
        u.pm = fm + ((wgid % nig) % gsz); u.pn = (wgid % nig) / gsz; return true;
    }
};
__device__ __forceinline__ unsigned cvt_pk_bf16(float lo, float hi) { unsigned r; asm volatile("v_cvt_pk_bf16_f32 %0, %1, %2" : "=v"(r) : "v"(lo), "v"(hi)); return r; }

struct EpiBf16 {
    static constexpr bool PERM = true;
    bf16_t* O; int ldc;
    __device__ __forceinline__ void operator()(const f32x4 (&acc)[2][2][4][2], const Unit& u, int wr, int wc, int fr, int fq) const {
        const int row0 = u.pm * BM + wr * 64 + fr; const int col0 = u.pn * BM + wc * 32 + 8 * fq;
#pragma unroll
        for (int ai = 0; ai < 2; ++ai)
#pragma unroll
            for (int m = 0; m < 4; ++m) { bf16_t* rowp = O + (size_t)(row0 + ai * HALF + m * 16) * ldc + col0;
#pragma unroll
                for (int bj = 0; bj < 2; ++bj) { const f32x4 v0 = acc[ai][bj][m][0], v1 = acc[ai][bj][m][1];
                    u32x4 w; w.x = cvt_pk_bf16(v0[0], v0[1]); w.y = cvt_pk_bf16(v0[2], v0[3]); w.z = cvt_pk_bf16(v1[0], v1[1]); w.w = cvt_pk_bf16(v1[2], v1[3]);
                    store16_wt(rowp + bj * HALF, w); } }
    }
};
struct EpiResid {
    static constexpr bool PERM = false;
    const float* xin; float* out; int ldc; const float* gate0; int gstride;
    __device__ __forceinline__ void operator()(const f32x4 (&acc)[2][2][4][2], const Unit& u, int wr, int wc, int fr, int fq) const {
        const int col0 = u.pn * BM + wc * 32 + 4 * fq; const float* gate = gate0 + (size_t)((u.pm * BM) / SEQ) * gstride;
        f32x4 gv[2][2];
#pragma unroll
        for (int bj = 0; bj < 2; ++bj)
#pragma unroll
            for (int n = 0; n < 2; ++n) gv[bj][n] = *(const f32x4*)(gate + col0 + bj * HALF + n * 16);
#pragma unroll
        for (int ai = 0; ai < 2; ++ai) {
            f32x4 xi[4][2][2];
#pragma unroll
            for (int m = 0; m < 4; ++m) { const size_t off = (size_t)(u.pm * BM + ai * HALF + wr * 64 + m * 16 + fr) * ldc + col0;
#pragma unroll
                for (int bj = 0; bj < 2; ++bj)
#pragma unroll
                    for (int n = 0; n < 2; ++n) xi[m][bj][n] = *(const f32x4*)(xin + off + bj * HALF + n * 16); }
#pragma unroll
            for (int m = 0; m < 4; ++m) { const size_t off = (size_t)(u.pm * BM + ai * HALF + wr * 64 + m * 16 + fr) * ldc + col0;
#pragma unroll
                for (int bj = 0; bj < 2; ++bj)
#pragma unroll
                    for (int n = 0; n < 2; ++n) { const f32x4 ov = xi[m][bj][n] + gv[bj][n] * acc[ai][bj][m][n]; store16_wt(out + off + bj * HALF + n * 16, ov); } }
        }
    }
};

template <class Epi, bool ALIGN_EPI = true>
__device__ __forceinline__ void gemm_phase(LAS unsigned char* lds, const Gemm g, const StaticOrder& S, const Epi& E) {
    const int tid = launder(tidx()), wid = __builtin_amdgcn_readfirstlane(tid >> 6), lane = tid & 63, wr = wid >> 2, wc = wid & 3, fr = lane & 15, fq = lane >> 4;
    const int K = g.K, nt = K / BK;
    unsigned voffA[2], voffB[2];
#pragma unroll
    for (int i = 0; i < 2; ++i) { int R, C; stage_rc(tid * 16 + i * 8192, R, C); const int Rb = Epi::PERM ? ((R & ~31) + perm32(R & 31)) : R;
        voffA[i] = (unsigned)(R * g.lda + C) * 2u; voffB[i] = (unsigned)(Rb * g.ldb + C) * 2u; }
    const size_t kstep = (size_t)(BK * 2);
    const size_t hstepA = (size_t)HALF * g.lda * 2, hstepB = (size_t)HALF * g.ldb * 2;
    const size_t tstepA = 2 * hstepA, tstepB = 2 * hstepB;
    const unsigned ldsw = (unsigned)wid * 1024u;
    const int aoff = lds_byte(wr * 64 + fr, fq * 8), boff = lds_byte(wc * 32 + fr, fq * 8);
#define PG8_SA(b, h) (((b) * 2 + (h)) * HTB)
#define PG8_SB(b, h) ((4 + (b) * 2 + (h)) * HTB)
#define PG8_STAGE(bufoff, gbase, voff) do { _Pragma("unroll") for (int _i = 0; _i < 2; ++_i) \
        __builtin_amdgcn_global_load_lds((const unsigned*)((const char*)(gbase) + (voff)[_i]), (LAS unsigned*)(lds + (bufoff) + ldsw + _i * 8192), 16, 0, 0); } while (0)
#define PG8_LDA(dst, b, h) do { _Pragma("unroll") for (int m = 0; m < 4; ++m) _Pragma("unroll") for (int k = 0; k < 2; ++k) dst[m][k] = *(const LAS bf16x8*)(lds + PG8_SA(b, h) + aoff + m * 2048 + k * 1024); } while (0)
#define PG8_LDB(dst, b, h) do { _Pragma("unroll") for (int n = 0; n < 2; ++n) _Pragma("unroll") for (int k = 0; k < 2; ++k) dst[n][k] = *(const LAS bf16x8*)(lds + PG8_SB(b, h) + boff + n * 2048 + k * 1024); } while (0)
#define PG8_MMA(ai, bj, At, Bt) do { __builtin_amdgcn_s_setprio(1); _Pragma("unroll") for (int m = 0; m < 4; ++m) _Pragma("unroll") for (int n = 0; n < 2; ++n) _Pragma("unroll") for (int k = 0; k < 2; ++k) \
        acc[ai][bj][m][n] = __builtin_amdgcn_mfma_f32_16x16x32_bf16(Bt[n][k], At[m][k], acc[ai][bj][m][n], 0, 0, 0); __builtin_amdgcn_s_setprio(0); } while (0)
#define PG8_WAIT_V(n) asm volatile("s_waitcnt vmcnt(" #n ")" ::: "memory")
#define PG8_WAIT_L(n) asm volatile("s_waitcnt lgkmcnt(" #n ")" ::: "memory")
#define PG8_BAR __builtin_amdgcn_s_barrier()
#define PG8_SCHED __builtin_amdgcn_sched_barrier(0)
    Unit cur, nxt; int ui = 0;
    if (!S.next(0, cur)) return;
    f32x4 acc[2][2][4][2];
#pragma unroll
    for (int a = 0; a < 2; ++a)
#pragma unroll
        for (int b = 0; b < 2; ++b)
#pragma unroll
            for (int m = 0; m < 4; ++m)
#pragma unroll
                for (int n = 0; n < 2; ++n) acc[a][b][m][n] = (f32x4){0.f, 0.f, 0.f, 0.f};
    bf16x8 At[4][2], B0[2][2], B1[2][2];
    const char* cA = (const char*)g.A + (size_t)cur.pm * tstepA; const char* cB = (const char*)g.Bt + (size_t)cur.pn * tstepB;
    {
        PG8_STAGE(PG8_SB(0, 0), cB, voffB); PG8_STAGE(PG8_SB(0, 1), cB + hstepB, voffB); PG8_STAGE(PG8_SA(0, 0), cA, voffA); PG8_STAGE(PG8_SA(0, 1), cA + hstepA, voffA);
        if (wr == 1) PG8_BAR;
        PG8_WAIT_V(2); PG8_BAR;
        PG8_STAGE(PG8_SB(1, 0), cB + kstep, voffB); PG8_STAGE(PG8_SA(1, 0), cA + kstep, voffA); PG8_STAGE(PG8_SB(1, 1), cB + hstepB + kstep, voffB);
        PG8_WAIT_V(6); PG8_BAR;
    }
    for (;;) {
        const bool has_next = S.next(ui + 1, nxt);
        const char* nA = has_next ? (const char*)g.A + (size_t)nxt.pm * tstepA : cA; const char* nB = has_next ? (const char*)g.Bt + (size_t)nxt.pn * tstepB : cB;
        for (int t = 0; t < nt; t += 2) {
            const bool last = (t == nt - 2);
            const char* a1 = cA + (size_t)(t + 1) * kstep;
            const char* a2 = last ? nA : cA + (size_t)(t + 2) * kstep; const char* b2 = last ? nB : cB + (size_t)(t + 2) * kstep;
            const char* a3 = a2 + kstep; const char* b3 = b2 + kstep;
            PG8_LDB(B0, 0, 0); PG8_LDB(B1, 0, 1); PG8_SCHED; PG8_LDA(At, 0, 0); PG8_STAGE(PG8_SA(1, 1), a1 + hstepA, voffA);
            PG8_WAIT_V(8); PG8_WAIT_L(0); PG8_BAR; PG8_MMA(0, 0, At, B0); PG8_MMA(0, 1, At, B1); PG8_BAR; PG8_SCHED;
            PG8_LDA(At, 0, 1); PG8_STAGE(PG8_SB(0, 0), b2, voffB); PG8_STAGE(PG8_SB(0, 1), b2 + hstepB, voffB); PG8_STAGE(PG8_SA(0, 0), a2, voffA);
            PG8_WAIT_V(8); PG8_WAIT_L(0); PG8_BAR; PG8_MMA(1, 0, At, B0); PG8_MMA(1, 1, At, B1); PG8_BAR; PG8_SCHED;
            PG8_LDB(B0, 1, 0); PG8_LDB(B1, 1, 1); PG8_SCHED; PG8_LDA(At, 1, 0); PG8_STAGE(PG8_SA(0, 1), a2 + hstepA, voffA);
            PG8_WAIT_V(8); PG8_WAIT_L(0); PG8_BAR; PG8_MMA(0, 0, At, B0); PG8_MMA(0, 1, At, B1); PG8_BAR; PG8_SCHED;
            PG8_LDA(At, 1, 1); PG8_STAGE(PG8_SB(1, 0), b3, voffB); PG8_STAGE(PG8_SB(1, 1), b3 + hstepB, voffB); PG8_STAGE(PG8_SA(1, 0), a3, voffA);
            PG8_WAIT_V(8); PG8_WAIT_L(0); PG8_BAR; PG8_MMA(1, 0, At, B0); PG8_MMA(1, 1, At, B1); PG8_BAR; PG8_SCHED;
        }
        if constexpr (ALIGN_EPI) { if (wr == 0) PG8_BAR; }
        { const int l2 = launder(tidx()) & 63; E(acc, cur, wr, wc, l2 & 15, l2 >> 4); }
        if (!has_next) break;
#pragma unroll
        for (int a = 0; a < 2; ++a)
#pragma unroll
            for (int b = 0; b < 2; ++b)
#pragma unroll
                for (int m = 0; m < 4; ++m)
#pragma unroll
                    for (int n = 0; n < 2; ++n) acc[a][b][m][n] = (f32x4){0.f, 0.f, 0.f, 0.f};
        cur = nxt; cA = nA; cB = nB; ++ui;
        if constexpr (ALIGN_EPI) { if (wr == 1) PG8_BAR; }
    }
    PG8_WAIT_V(0);
    if constexpr (!ALIGN_EPI) { if (wr == 0) PG8_BAR; }
    PG8_BAR;
#undef PG8_SA
#undef PG8_SB
#undef PG8_STAGE
#undef PG8_LDA
#undef PG8_LDB
#undef PG8_MMA
#undef PG8_WAIT_V
#undef PG8_WAIT_L
#undef PG8_BAR
#undef PG8_SCHED
}
}

namespace att {
constexpr int SLOT = 20480, KOFF = 0, VOFF = 12288;
constexpr int L_WSF = 4 * SLOT, L_OST = L_WSF + 2048, L_END = L_OST + 8 * 4096;
constexpr float THR = 8.f;
__device__ __forceinline__ int crow(int r, int hi) { return (r & 3) + 8 * (r >> 2) + 4 * hi; }
__device__ __forceinline__ void glds16(const void* gsrc, unsigned lds_dst) { unsigned keep;
    asm volatile("s_mov_b32 %0, m0\n\ts_mov_b32 m0, %2\n\ts_nop 0\n\tglobal_load_lds_dwordx4 %1, off\n\ts_mov_b32 m0, %0" : "=&s"(keep) : "v"(gsrc), "s"(lds_dst) : "memory"); }
__device__ __forceinline__ void glds16s(const void* sbase, unsigned voff, unsigned lds_dst) { unsigned keep;
    asm volatile("s_mov_b32 %0, m0\n\ts_mov_b32 m0, %3\n\ts_nop 0\n\tglobal_load_lds_dwordx4 %1, %2\n\ts_mov_b32 m0, %0" : "=&s"(keep) : "v"(voff), "s"(sbase), "s"(lds_dst) : "memory"); }
__device__ __forceinline__ unsigned cvtpk_s(float lo, float hi) { typedef __bf16 bf16x2_t __attribute__((ext_vector_type(2))); f32x2 v = {lo, hi}; bf16x2_t b = __builtin_convertvector(v, bf16x2_t); return __builtin_bit_cast(unsigned, b); }
typedef short v4i16_t __attribute__((ext_vector_type(4)));
__device__ __forceinline__ s16x4 vtr(const LAS char* p) { return __builtin_bit_cast(s16x4, __builtin_amdgcn_ds_read_tr16_b64_v4i16((LAS v4i16_t*)p)); }
#define ATT_WAIT_BAR() asm volatile("s_waitcnt vmcnt(0) lgkmcnt(0)\n\ts_barrier" ::: "memory")
#define MX3(a, b, c) __builtin_fmaxf(__builtin_fmaxf((a), (b)), (c))
#define SBAR() __builtin_amdgcn_sched_barrier(0)
__device__ __forceinline__ int bucket(int d) { if (d < 16) return d; const int b = 39 - __builtin_clz((unsigned)(d * d)); return b > 31 ? 31 : b; }

struct Tens { const bf16_t* Q; int qp; const bf16_t* K; int kp; const bf16_t* V; int vp; const bf16_t* G; int gp; bf16_t* O; int op; float Bshift; };

template <int NKD>
__device__ __forceinline__ void unit(const Tens& T, int b, int qb, LAS char* lds, unsigned* qnext, volatile LAS unsigned* qslot) {
    const int tid = launder(tidx()), lane = tid & 63, r32 = lane & 31, hi = lane >> 5; const int wid = __builtin_amdgcn_readfirstlane(tid >> 6);
    const bool g1 = wid >= 4;
    const long rowbase = (long)b * SEQ; const int q0 = qb * 256, NT = 4 * qb + 4;
    const int qpos = q0 + wid * 32 + r32;
    const unsigned lds0 = (unsigned)(uintptr_t)lds;
    LAS float* wsf = (LAS float*)(lds + L_WSF) + wid * 64;
    static_assert(NKD == 6, "the counted vmcnt below assumes 5 LDS-DMA pieces per wave and tile");
    const int w4 = wid & 3;
    const unsigned koff = (unsigned)((lane * T.kp + w4 * 8) * 2);
    const unsigned voff = (unsigned)(((16 * w4 + (lane >> 2)) * T.vp + (lane & 3) * 8) * 2);
    auto dmaK = [&](int t) {
        const unsigned kd = (unsigned)__builtin_amdgcn_readfirstlane((int)(lds0 + (t & 3) * SLOT + KOFF + w4 * 1024));
        const bf16_t* kb_ = T.K + (rowbase + (long)t * 64) * (long)T.kp;
        glds16s(kb_, koff, kd); glds16s(kb_ + 32, koff, kd + 4096); glds16s(kb_ + 64, koff, kd + 8192);
    };
    auto dmaV = [&](int t) {
        const unsigned vd = (unsigned)__builtin_amdgcn_readfirstlane((int)(lds0 + (t & 3) * SLOT + VOFF + w4 * 1024));
        const bf16_t* vb_ = T.V + (rowbase + (long)t * 64) * (long)T.vp;
        glds16s(vb_, voff, vd); glds16s(vb_ + 32, voff, vd + 4096);
    };
    if (g1) { dmaK(0); dmaK(1); } else { dmaV(0); dmaV(1); }
    bf16x8 qr[NKD];
    { const bf16_t* Qw = T.Q + (rowbase + qpos) * (long)T.qp;
#pragma unroll
      for (int d0 = 0; d0 < NKD; ++d0) qr[d0] = *(const bf16x8*)(Qw + d0 * 16 + hi * 8); }
    float l_reg = 0.f; f32x16 o[2]; o[0] = f32x16{}; o[1] = f32x16{};
    unsigned nx_ = 0u;
    const LAS char* vp0 = lds + VOFF + ((lane >> 4) & 1) * 32 + (lane & 3) * 8 + (4 * hi + ((lane & 15) >> 2)) * 64;
    const LAS char* kp0 = lds + KOFF + hi * 1024 + r32 * 16;
#pragma unroll
    for (int d0 = 0; d0 < NKD; ++d0) asm volatile("" : "+v"(qr[d0]));
    f32x16 p0 = f32x16{}, p1 = f32x16{}; u32x4 pw[4]; bool pend = false;
    s16x4 vlo[4], vhh[4];
#pragma unroll
    for (int i = 0; i < 4; ++i) pw[i] = (u32x4){0u, 0u, 0u, 0u};
#pragma unroll
    for (int i = 0; i < 4; ++i) { vlo[i] = s16x4{}; vhh[i] = s16x4{}; }
    auto tile_act = [&](int t) -> bool { const int jb = t - (NT - 4); return (jb < 0) || (2 * jb <= wid); };
    auto pre = [&](int t, bool rk, bool rv) {
        if (rv) { const LAS char* vb = vp0 + ((t - 1) & 3) * SLOT;
#pragma unroll
            for (int i = 0; i < 4; ++i) { vlo[i] = vtr(vb + i * 1024); vhh[i] = vtr(vb + i * 1024 + 512); } }
        (void)rk;
    };
    auto pv = [&](int tv) {
        const LAS char* vb = vp0 + (tv & 3) * SLOT + 4096; s16x4 wlo[4], whh[4];
#pragma unroll
        for (int i = 0; i < 4; ++i) { wlo[i] = vtr(vb + i * 1024); whh[i] = vtr(vb + i * 1024 + 512); }
        SBAR();
#pragma unroll
        for (int ks = 0; ks < 4; ++ks) {
            { const bf16x8 vf = (bf16x8){vlo[ks][0], vlo[ks][1], vlo[ks][2], vlo[ks][3], vhh[ks][0], vhh[ks][1], vhh[ks][2], vhh[ks][3]};
              o[0] = __builtin_amdgcn_mfma_f32_32x32x16_bf16(__builtin_bit_cast(bf16x8, pw[ks]), vf, o[0], 0, 0, 0); }
            if (ks > 0) { const int k1 = ks - 1; const bf16x8 vf = (bf16x8){wlo[k1][0], wlo[k1][1], wlo[k1][2], wlo[k1][3], whh[k1][0], whh[k1][1], whh[k1][2], whh[k1][3]};
              o[1] = __builtin_amdgcn_mfma_f32_32x32x16_bf16(__builtin_bit_cast(bf16x8, pw[k1]), vf, o[1], 0, 0, 0); }
        }
        { const bf16x8 vf = (bf16x8){wlo[3][0], wlo[3][1], wlo[3][2], wlo[3][3], whh[3][0], whh[3][1], whh[3][2], whh[3][3]};
          o[1] = __builtin_amdgcn_mfma_f32_32x32x16_bf16(__builtin_bit_cast(bf16x8, pw[3]), vf, o[1], 0, 0, 0); }
    };
    auto qk = [&](const bf16x8 (&kf)[2 * NKD]) {
        p0 = f32x16{}; p1 = f32x16{};
#pragma unroll
        for (int d0 = 0; d0 < NKD; ++d0) {
            p0 = __builtin_amdgcn_mfma_f32_32x32x16_bf16(kf[2 * d0], qr[d0], p0, 0, 0, 0);
            p1 = __builtin_amdgcn_mfma_f32_32x32x16_bf16(kf[2 * d0 + 1], qr[d0], p1, 0, 0, 0); }
    };
    auto h1 = [&](int t, bool full) {
        const bool aq = full || tile_act(t);
        if (aq) { const LAS char* kb = kp0 + (t & 3) * SLOT; bf16x8 kf[2 * NKD];
#pragma unroll
            for (int d0 = 0; d0 < NKD; ++d0) { kf[2 * d0] = *(const LAS bf16x8*)(kb + d0 * 2048); kf[2 * d0 + 1] = *(const LAS bf16x8*)(kb + d0 * 2048 + 512); }
            if (full || pend) pv(t - 1);
            qk(kf);
        } else if (pend) pv(t - 1);
        pend = false; };
    auto h2 = [&](int t, bool full) {
        if (!full && !tile_act(t)) return;
        const int jb = full ? -1 : t - (NT - 4);
        if (jb >= 0) { const int lb = launder(tidx()) & 63, qposb = q0 + wid * 32 + (lb & 31); const int kbase = 64 * t + 4 * (lb >> 5);
#pragma unroll
            for (int r = 0; r < 16; ++r) { const int kv = kbase + (r & 3) + 8 * (r >> 2); if (kv > qposb) p0[r] = -INFINITY; if (kv + 32 > qposb) p1[r] = -INFINITY; } }
        float sacc = 0.f;
#pragma unroll
        for (int r = 0; r < 16; ++r) { p0[r] = __builtin_amdgcn_exp2f(p0[r]); p1[r] = __builtin_amdgcn_exp2f(p1[r]); sacc += p0[r] + p1[r]; }
        l_reg += sacc;
#pragma unroll
        for (int i = 0; i < 4; ++i) { pw[0][i] = cvtpk_s(p0[2 * i], p0[2 * i + 1]); pw[1][i] = cvtpk_s(p0[8 + 2 * i], p0[8 + 2 * i + 1]); pw[2][i] = cvtpk_s(p1[2 * i], p1[2 * i + 1]); pw[3][i] = cvtpk_s(p1[8 + 2 * i], p1[8 + 2 * i + 1]); }
        pend = true;
    };
    auto fin = [&]() {
        u32x4 gpf[4];
        { const int le = launder(tidx()) & 63; const long or0 = rowbase + q0 + wid * 32;
#pragma unroll
          for (int i = 0; i < 4; ++i) gpf[i] = *(const u32x4*)(T.G + (or0 + i * 8 + (le >> 3)) * (long)T.gp + (le & 7) * 8); }
        SBAR();
        if (pend) pv(NT - 1);
        pend = false;
        if (launder(tidx()) == 0) *qslot = nx_;
        { auto rr = __builtin_amdgcn_permlane32_swap(__float_as_uint(l_reg), __float_as_uint(l_reg), false, false); l_reg = __uint_as_float(rr[0]) + __uint_as_float(rr[1]); }
        const int lf = launder(tidx()) & 63, r32f = lf & 31, hif = lf >> 5;
        if (hif == 0) wsf[32 + r32f] = l_reg;
        float rli[16];
#pragma unroll
        for (int r = 0; r < 16; ++r) rli[r] = 1.0f / wsf[32 + crow(r, hif)];
        LAS bf16_t* stg = (LAS bf16_t*)(lds + L_OST) + wid * 2048;
#pragma unroll
        for (int r = 0; r < 16; ++r) { const int orow = crow(r, hif);
#pragma unroll
            for (int d0 = 0; d0 < 2; ++d0) stg[orow * 64 + d0 * 32 + r32f] = (bf16_t)f2bf(o[d0][r] * rli[r]); }
        LDS_WAIT();
        const long orow0 = rowbase + q0 + wid * 32; const int lane_e = launder(tidx()) & 63;
#pragma unroll
        for (int i = 0; i < 4; ++i) { const int row = i * 8 + (lane_e >> 3), ch = lane_e & 7;
            const u32x4 ov = *(const LAS u32x4*)(stg + row * 64 + ch * 8);
            const u32x4 gv = gpf[i];
            u32x4 res;
#pragma unroll
            for (int e = 0; e < 4; ++e) { const float g0 = bflo(gv[e]), g1_ = bfhi(gv[e]);
                const float s0 = g0 / (1.0f + __expf(-g0)), s1 = g1_ / (1.0f + __expf(-g1_));
                res[e] = pk2(bflo(ov[e]) * s0, bfhi(ov[e]) * s1); }
            store16_wt(T.O + (orow0 + row) * (long)T.op + ch * 8, res); }
    };
#define ATT_BE() asm volatile("s_waitcnt lgkmcnt(0)\n\ts_barrier" ::: "memory")
#define ATT_BO5() asm volatile("s_waitcnt vmcnt(3) lgkmcnt(0)\n\ts_barrier" ::: "memory")
#define ATT_BO0() asm volatile("s_waitcnt vmcnt(0) lgkmcnt(0)\n\ts_barrier" ::: "memory")
    asm volatile("s_waitcnt vmcnt(0) lgkmcnt(0)\n\ts_barrier" ::: "memory");
    if (!g1) {
        pre(0, true, false);
        ATT_BE(); h1(0, false); ATT_BO0(); dmaV(2); pre(1, tile_act(1), tile_act(0)); h2(0, NT > 4);
        int t = 1;
        for (; t < NT - 4; ++t) { ATT_BE(); h1(t, true); ATT_BO0(); dmaV(t + 2); pre(t + 1, true, true); h2(t, true); }
        const int tf = t;
        for (; t < NT; ++t) { ATT_BE(); h1(t, false); ATT_BO0(); if (t == tf && launder(tidx()) == 0) nx_ = __hip_atomic_fetch_add(qnext, 1u, __ATOMIC_RELAXED, __HIP_MEMORY_SCOPE_AGENT); if (t + 2 < NT) dmaV(t + 2); pre(t + 1, (t + 1 < NT) && tile_act(t + 1), tile_act(t)); h2(t, false); }
        ATT_BE(); fin(); ATT_BO0();
    } else {
        ATT_BE(); dmaK(2); pre(0, true, false); ATT_BO5(); h1(0, false);
        int t = 1;
        for (; t < NT - 4; ++t) { ATT_BE(); dmaK(t + 2); pre(t, true, true); h2(t - 1, true); ATT_BO5(); h1(t, true); }
        for (; t < NT; ++t) { ATT_BE(); const bool more = t + 2 < NT; if (more) dmaK(t + 2); pre(t, tile_act(t), tile_act(t - 1)); h2(t - 1, t - 1 < NT - 4); if (more) ATT_BO5(); else ATT_BO0(); h1(t, false); }
        ATT_BE(); pre(NT, false, tile_act(NT - 1)); h2(NT - 1, false); ATT_BO0(); fin();
    }
#undef ATT_BE
#undef ATT_BO5
#undef ATT_BO0
    asm volatile("s_waitcnt lgkmcnt(0)\n\ts_barrier" ::: "memory");
}
}


namespace moba {
constexpr int L_PL = 0, L_LPL = 98304, L_BIAS = L_LPL + 3072, L_LIST = L_BIAS + 32768, LIST_N = 1792, L_TILES = L_LIST + LIST_N * 2, L_CNT = L_TILES + 256, L_START = L_CNT + 512, L_MISC = L_START + 128, L_END = L_MISC + 64;
using att::crow; using att::cvtpk_s; using att::bucket;
struct Tens { const bf16_t* Q; int qp; const bf16_t* G; int gp; bf16_t* O; int op; const float* kpart; const float* bias; const bf16_t* KF; const bf16_t* VF; float Bshift; };

template <bool OWN>
__device__ __forceinline__ void tile(const Tens& T, const LAS float* biasL, int bh, int j, int nst, int qpos, bool valid, long rowbase, int lane, int hi, f32x16 (&o)[2], float& lsum) {
    bf16x8 qr[4];
    { const bf16_t* Qw = T.Q + (rowbase + qpos) * (long)T.qp;
#pragma unroll
      for (int d0 = 0; d0 < 4; ++d0) qr[d0] = *(const bf16x8*)(Qw + d0 * 16 + hi * 8); }
    o[0] = f32x16{}; o[1] = f32x16{}; lsum = 0.f;
    const bf16_t* kfp = T.KF + (((size_t)bh * 256 + (size_t)j * 8) * 4 * 64 + lane) * 8;
    const bf16_t* vfp = T.VF + (((size_t)bh * 512 + (size_t)j * 16) * 2 * 64 + lane) * 8;
    bf16x8 kf[8], vf[8];
#pragma unroll
    for (int d0 = 0; d0 < 4; ++d0) { kf[2 * d0] = *(const bf16x8*)(kfp + (0 * 4 + d0) * 512); kf[2 * d0 + 1] = *(const bf16x8*)(kfp + (1 * 4 + d0) * 512); }
#pragma unroll
    for (int k = 0; k < 4; ++k) { vf[k] = *(const bf16x8*)(vfp + ((size_t)k * 2 + 0) * 512); vf[4 + k] = *(const bf16x8*)(vfp + ((size_t)k * 2 + 1) * 512); }
    f32x16 p0, p1; float cm; u32x4 pw[4];
    auto qk_bias = [&](int st) {
        const int sn = (st + 1 < nst) ? st + 1 : st;
        p0 = f32x16{}; p1 = f32x16{};
#pragma unroll
        for (int d0 = 0; d0 < 4; ++d0) {
            p0 = __builtin_amdgcn_mfma_f32_32x32x16_bf16(kf[2 * d0], qr[d0], p0, 0, 0, 0);
            p1 = __builtin_amdgcn_mfma_f32_32x32x16_bf16(kf[2 * d0 + 1], qr[d0], p1, 0, 0, 0); }
#pragma unroll
        for (int d0 = 0; d0 < 4; ++d0) { kf[2 * d0] = *(const bf16x8*)(kfp + ((size_t)(2 * sn) * 4 + d0) * 512); kf[2 * d0 + 1] = *(const bf16x8*)(kfp + ((size_t)(2 * sn + 1) * 4 + d0) * 512); }
        const int keybase = 256 * j + 64 * st, kb4 = keybase + 4 * hi;
        if (!OWN || st + 1 < nst) {
            const int dmin = qpos - keybase - 63, dmax = qpos - keybase;
            const bool uni = bucket(dmin) == bucket(dmax);
            float c = 0.f;
            if (__all(uni)) c = biasL[dmin];
            else {
                const LAS float* bp = biasL + (qpos - kb4 - 59);
#pragma unroll
                for (int r = 0; r < 16; ++r) { const int cr = (r & 3) + 8 * (r >> 2); p0[r] += bp[59 - cr]; p1[r] += bp[59 - cr - 32]; }
            }
            cm = valid ? (c - T.Bshift) : -INFINITY;
        } else {
#pragma unroll
            for (int r = 0; r < 16; ++r) { const int kv = kb4 + (r & 3) + 8 * (r >> 2); const int d0_ = qpos - kv, d1_ = d0_ - 32;
                const float b0 = biasL[__builtin_elementwise_max(d0_, 0)], b1 = biasL[__builtin_elementwise_max(d1_, 0)];
                p0[r] = (d0_ >= 0) ? p0[r] + b0 : -INFINITY; p1[r] = (d1_ >= 0) ? p1[r] + b1 : -INFINITY; }
            cm = -T.Bshift;
        }
    };
    auto pack = [&]() {
#pragma unroll
        for (int i = 0; i < 4; ++i) { pw[0][i] = cvtpk_s(p0[2 * i], p0[2 * i + 1]); pw[1][i] = cvtpk_s(p0[8 + 2 * i], p0[8 + 2 * i + 1]); pw[2][i] = cvtpk_s(p1[2 * i], p1[2 * i + 1]); pw[3][i] = cvtpk_s(p1[8 + 2 * i], p1[8 + 2 * i + 1]); }
    };
    qk_bias(0);
    { float sacc = 0.f;
#pragma unroll
      for (int r = 0; r < 16; ++r) { p0[r] = __builtin_amdgcn_exp2f(p0[r] + cm); p1[r] = __builtin_amdgcn_exp2f(p1[r] + cm); sacc += p0[r] + p1[r]; }
      lsum += sacc; }
    pack();
#pragma unroll 1
    for (int st = 1; st < nst; ++st) {
        qk_bias(st);
        float sacc = 0.f;
#pragma unroll
        for (int g = 0; g < 8; ++g) {
            o[g >> 2] = __builtin_amdgcn_mfma_f32_32x32x16_bf16(__builtin_bit_cast(bf16x8, pw[g & 3]), vf[g], o[g >> 2], 0, 0, 0);
#pragma unroll
            for (int e = 0; e < 2; ++e) { const int r = 2 * g + e; p0[r] = __builtin_amdgcn_exp2f(p0[r] + cm); p1[r] = __builtin_amdgcn_exp2f(p1[r] + cm); sacc += p0[r] + p1[r]; }
        }
        lsum += sacc;
#pragma unroll
        for (int k = 0; k < 4; ++k) { vf[k] = *(const bf16x8*)(vfp + ((size_t)(4 * st + k) * 2 + 0) * 512); vf[4 + k] = *(const bf16x8*)(vfp + ((size_t)(4 * st + k) * 2 + 1) * 512); }
        pack();
    }
#pragma unroll
    for (int g = 0; g < 8; ++g) o[g >> 2] = __builtin_amdgcn_mfma_f32_32x32x16_bf16(__builtin_bit_cast(bf16x8, pw[g & 3]), vf[g], o[g >> 2], 0, 0, 0);
}

__device__ __forceinline__ void pair_stream(const Tens& T, const LAS float* biasL, int bh, int q0, long rowbase, int lane, int r32, int hi, unsigned ntiles,
                                            LAS unsigned* misc, const LAS unsigned* tiles, const LAS unsigned short* list, LAS bf16_t* pl, LAS float* lpl) {
    auto fetch = [&]() -> unsigned { unsigned ti = 0u; if (lane == 0) ti = __hip_atomic_fetch_add(misc, 1u, __ATOMIC_RELAXED, __HIP_MEMORY_SCOPE_WORKGROUP); return (unsigned)__builtin_amdgcn_readfirstlane((int)ti); };
    unsigned ti = fetch();
    if (ti >= ntiles) return;
    unsigned te = tiles[ti]; int off = (int)(te & 0xffffu), j = (int)(te >> 16);
    unsigned v16 = list[off + r32]; bool valid = v16 != 0xFFFFu; int qpos = q0 + (valid ? (int)(v16 & 255u) : 0);
    bf16x8 qr[4], qn[4], kf[8], vf[8];
    { const bf16_t* Qw = T.Q + (rowbase + qpos) * (long)T.qp;
#pragma unroll
      for (int d0 = 0; d0 < 4; ++d0) qr[d0] = *(const bf16x8*)(Qw + d0 * 16 + hi * 8); }
    const bf16_t* kfp = T.KF + (((size_t)bh * 256 + (size_t)j * 8) * 4 * 64 + lane) * 8;
    const bf16_t* vfp = T.VF + (((size_t)bh * 512 + (size_t)j * 16) * 2 * 64 + lane) * 8;
#pragma unroll
    for (int d0 = 0; d0 < 4; ++d0) { kf[2 * d0] = *(const bf16x8*)(kfp + (0 * 4 + d0) * 512); kf[2 * d0 + 1] = *(const bf16x8*)(kfp + (1 * 4 + d0) * 512); }
#pragma unroll
    for (int k = 0; k < 4; ++k) { vf[k] = *(const bf16x8*)(vfp + ((size_t)k * 2 + 0) * 512); vf[4 + k] = *(const bf16x8*)(vfp + ((size_t)k * 2 + 1) * 512); }
#pragma unroll
    for (int d0 = 0; d0 < 4; ++d0) qn[d0] = qr[d0];
#pragma unroll 1
    for (;;) {
        unsigned tn = ti; bool hn = false; int offn = off, jn = j; unsigned v16n = v16; bool validn = valid; int qposn = qpos; const bf16_t* kfn = kfp;
        f32x16 o[2]; o[0] = f32x16{}; o[1] = f32x16{}; float lsum = 0.f;
        f32x16 p0, p1; u32x4 pw[4];
        auto qk_bias = [&](int st) {
            const int keybase = 256 * j + 64 * st, kb4 = keybase + 4 * hi;
            const int dmin = qpos - keybase - 63, dmax = qpos - keybase;
            const bool allu = __all(bucket(dmin) == bucket(dmax));
            const float cinit = valid ? ((allu ? biasL[dmin] : 0.f) - T.Bshift) : -INFINITY;
            f32x16 ci;
#pragma unroll
            for (int r = 0; r < 16; ++r) ci[r] = cinit;
            p0 = __builtin_amdgcn_mfma_f32_32x32x16_bf16(kf[0], qr[0], ci, 0, 0, 0);
            p1 = __builtin_amdgcn_mfma_f32_32x32x16_bf16(kf[1], qr[0], ci, 0, 0, 0);
#pragma unroll
            for (int d0 = 1; d0 < 4; ++d0) {
                p0 = __builtin_amdgcn_mfma_f32_32x32x16_bf16(kf[2 * d0], qr[d0], p0, 0, 0, 0);
                p1 = __builtin_amdgcn_mfma_f32_32x32x16_bf16(kf[2 * d0 + 1], qr[d0], p1, 0, 0, 0); }
            const bf16_t* ksrc = (st < 3) ? kfp + (size_t)(2 * (st + 1)) * 4 * 512 : kfn;
#pragma unroll
            for (int d0 = 0; d0 < 4; ++d0) { kf[2 * d0] = *(const bf16x8*)(ksrc + (0 * 4 + d0) * 512); kf[2 * d0 + 1] = *(const bf16x8*)(ksrc + (1 * 4 + d0) * 512); }
            if (st == 3) { const bf16_t* Qw = T.Q + (rowbase + qposn) * (long)T.qp;
#pragma unroll
                for (int d0 = 0; d0 < 4; ++d0) qn[d0] = *(const bf16x8*)(Qw + d0 * 16 + hi * 8); }
            if (!allu) {
                const LAS float* bp = biasL + (qpos - kb4 - 59);
#pragma unroll
                for (int r = 0; r < 16; ++r) { const int cr = (r & 3) + 8 * (r >> 2); p0[r] += bp[59 - cr]; p1[r] += bp[59 - cr - 32]; }
            }
        };
        auto pack = [&]() {
#pragma unroll
            for (int i = 0; i < 4; ++i) { pw[0][i] = cvtpk_s(p0[2 * i], p0[2 * i + 1]); pw[1][i] = cvtpk_s(p0[8 + 2 * i], p0[8 + 2 * i + 1]); pw[2][i] = cvtpk_s(p1[2 * i], p1[2 * i + 1]); pw[3][i] = cvtpk_s(p1[8 + 2 * i], p1[8 + 2 * i + 1]); }
        };
        qk_bias(0);
        { float sacc;
#pragma unroll
          for (int r = 0; r < 16; ++r) { p0[r] = __builtin_amdgcn_exp2f(p0[r]); p1[r] = __builtin_amdgcn_exp2f(p1[r]); }
          f32x2 s2 = {0.f, 0.f};
#pragma unroll
          for (int i = 0; i < 8; ++i) { s2 += (f32x2){p0[2 * i], p0[2 * i + 1]}; s2 += (f32x2){p1[2 * i], p1[2 * i + 1]}; }
          sacc = s2.x + s2.y; lsum += sacc; }
        pack();
#pragma unroll 1
        for (int st = 1; st < 4; ++st) {
            if (st == 2) { tn = fetch(); hn = tn < ntiles;
                const unsigned ten = tiles[hn ? tn : ti]; offn = (int)(ten & 0xffffu); jn = (int)(ten >> 16);
                v16n = list[offn + r32]; validn = v16n != 0xFFFFu; qposn = q0 + (validn ? (int)(v16n & 255u) : 0);
                kfn = T.KF + (((size_t)bh * 256 + (size_t)jn * 8) * 4 * 64 + lane) * 8; }
            qk_bias(st);
            f32x2 s2 = {0.f, 0.f};
#pragma unroll
            for (int g = 0; g < 8; ++g) {
                o[g >> 2] = __builtin_amdgcn_mfma_f32_32x32x16_bf16(__builtin_bit_cast(bf16x8, pw[g & 3]), vf[g], o[g >> 2], 0, 0, 0);
                p0[2 * g] = __builtin_amdgcn_exp2f(p0[2 * g]); p0[2 * g + 1] = __builtin_amdgcn_exp2f(p0[2 * g + 1]); p1[2 * g] = __builtin_amdgcn_exp2f(p1[2 * g]); p1[2 * g + 1] = __builtin_amdgcn_exp2f(p1[2 * g + 1]);
                s2 += (f32x2){p0[2 * g], p0[2 * g + 1]}; s2 += (f32x2){p1[2 * g], p1[2 * g + 1]};
            }
            lsum += s2.x + s2.y;
#pragma unroll
            for (int k = 0; k < 4; ++k) { vf[k] = *(const bf16x8*)(vfp + ((size_t)(4 * st + k) * 2 + 0) * 512); vf[4 + k] = *(const bf16x8*)(vfp + ((size_t)(4 * st + k) * 2 + 1) * 512); }
            pack();
        }
#pragma unroll
        for (int g = 0; g < 8; ++g) o[g >> 2] = __builtin_amdgcn_mfma_f32_32x32x16_bf16(__builtin_bit_cast(bf16x8, pw[g & 3]), vf[g], o[g >> 2], 0, 0, 0);
        const bf16_t* vfn = T.VF + (((size_t)bh * 512 + (size_t)jn * 16) * 2 * 64 + lane) * 8;
#pragma unroll
        for (int k = 0; k < 4; ++k) { vf[k] = *(const bf16x8*)(vfn + ((size_t)k * 2 + 0) * 512); vf[4 + k] = *(const bf16x8*)(vfn + ((size_t)k * 2 + 1) * 512); }
        { auto rr = __builtin_amdgcn_permlane32_swap(__float_as_uint(lsum), __float_as_uint(lsum), false, false); lsum = __uint_as_float(rr[0]) + __uint_as_float(rr[1]); }
        if (hi == 0 && valid) lpl[((v16 >> 8) & 3u) * 256 + (int)(v16 & 255u)] = lsum;
        unsigned er[16];
#pragma unroll
        for (int r = 0; r < 16; ++r) er[r] = list[off + crow(r, hi)];
#pragma unroll
        for (int r = 0; r < 16; ++r) if (er[r] != 0xFFFFu) { LAS bf16_t* dst = pl + ((er[r] >> 8) & 3u) * 16384 + (er[r] & 255u) * 64 + r32;
            const unsigned w2 = pk2(o[0][r], o[1][r]); dst[0] = (bf16_t)(w2 & 0xffffu); dst[32] = (bf16_t)(w2 >> 16); }
        if (!hn) break;
        ti = tn; off = offn; j = jn; v16 = v16n; valid = validn; qpos = qposn; kfp = kfn; vfp = vfn;
#pragma unroll
        for (int d0 = 0; d0 < 4; ++d0) qr[d0] = qn[d0];
    }
}

__device__ __forceinline__ void unit(const Tens& T, int b, int h, int qb, LAS char* lds, unsigned* qnext, volatile LAS unsigned* qslot) {
    const int tid = launder(tidx()), lane = tid & 63, r32 = lane & 31, hi = lane >> 5; const int wid = __builtin_amdgcn_readfirstlane(tid >> 6);
    const long rowbase = (long)b * SEQ; const int q0 = qb * 256, bh = b * 8 + h;
    LAS bf16_t* pl = (LAS bf16_t*)(lds + L_PL); LAS float* lpl = (LAS float*)(lds + L_LPL);
    const LAS float* biasL = (const LAS float*)(lds + L_BIAS);
    LAS unsigned short* list = (LAS unsigned short*)(lds + L_LIST);
    LAS unsigned* tiles = (LAS unsigned*)(lds + L_TILES); LAS unsigned* cntw = (LAS unsigned*)(lds + L_CNT); LAS unsigned* startv = (LAS unsigned*)(lds + L_START);
    LAS unsigned* misc = (LAS unsigned*)(lds + L_MISC);
    const int npick = qb < 3 ? qb : 3;
    f32x4 bt[4];
#pragma unroll
    for (int i = 0; i < 4; ++i) bt[i] = *(const f32x4*)(T.bias + (tid + 512 * i) * 4);
    for (int i = tid; i < LIST_N / 2; i += 512) ((LAS unsigned*)(lds + L_LIST))[i] = 0xFFFFFFFFu;
    if (tid == 0) misc[0] = 0u;
    unsigned selm = 0u;
    if (qb > 0) {
        LAS float* kmL = (LAS float*)(lds + L_PL);
        LAS float* part = (LAS float*)(lds + L_PL + 8192);
        const int r = tid & 255, half = tid >> 8;
        u32x4 qw_[4];
        { const bf16_t* qp_ = T.Q + (rowbase + q0 + r) * (long)T.qp + 32 * half;
#pragma unroll
          for (int c = 0; c < 4; ++c) qw_[c] = *(const u32x4*)(qp_ + 8 * c); }
        float ks_[4][4];
#pragma unroll
        for (int k = 0; k < 4; ++k) { const int idx = tid + 512 * k, idc = idx < qb * 64 ? idx : 0, j = idc >> 6, d = idc & 63;
            const float* p = T.kpart + ((size_t)(b * 32 + j) * 4) * 512 + h * 64 + d;
#pragma unroll
            for (int c = 0; c < 4; ++c) ks_[k][c] = p[512 * c]; }
        SBAR();
#pragma unroll
        for (int k = 0; k < 4; ++k) { const int idx = tid + 512 * k; if (idx < qb * 64) kmL[idx] = (((ks_[k][0] + ks_[k][1]) + ks_[k][2]) + ks_[k][3]) * (1.0f / 256.0f); }
        float q[32];
#pragma unroll
        for (int c = 0; c < 4; ++c)
#pragma unroll
            for (int e = 0; e < 4; ++e) { q[8 * c + 2 * e] = bflo(qw_[c][e]); q[8 * c + 2 * e + 1] = bfhi(qw_[c][e]); }
        __syncthreads();
        for (int j = 0; j < qb; ++j) { const LAS float* kmp = kmL + j * 64 + 32 * half; float d0 = 0.f, d1 = 0.f, d2 = 0.f, d3 = 0.f;
#pragma unroll
            for (int c = 0; c < 8; ++c) { const f32x4 kv = *(const LAS f32x4*)(kmp + 4 * c); d0 += q[4 * c] * kv.x; d1 += q[4 * c + 1] * kv.y; d2 += q[4 * c + 2] * kv.z; d3 += q[4 * c + 3] * kv.w; }
            part[(half * 32 + j) * 256 + r] = (d0 + d1) + (d2 + d3); }
        __syncthreads();
        if (tid < 256) {
            float v0 = -INFINITY, v1 = -INFINITY, v2 = -INFINITY; int i0 = 0, i1 = 0, i2 = 0;
            for (int j = 0; j < qb; ++j) { const float d = part[j * 256 + tid] + part[(32 + j) * 256 + tid];
                if (d > v0) { v2 = v1; i2 = i1; v1 = v0; i1 = i0; v0 = d; i0 = j; } else if (d > v1) { v2 = v1; i2 = i1; v1 = d; i1 = j; } else if (d > v2) { v2 = d; i2 = j; } }
            selm = 1u << i0; if (qb > 1) selm |= 1u << i1; if (qb > 2) selm |= 1u << i2;
        }
    }
    int pj0 = 0, pj1 = 0, pj2 = 0; unsigned pr0 = 0u, pr1 = 0u, pr2 = 0u;
    if (wid < 4) {
        unsigned mycnt = 0u;
        for (int j = 0; j < qb; ++j) { const unsigned bit = (selm >> j) & 1u; const unsigned long long m = __ballot(bit);
            const unsigned c = (unsigned)__popcll(m), rank = (unsigned)__popcll(m & ((1ull << lane) - 1ull)), kk = (unsigned)__popc(selm & ((1u << j) - 1u));
            mycnt = (lane == j) ? c : mycnt;
            if (bit && kk == 0u) { pj0 = j; pr0 = rank; }
            if (bit && kk == 1u) { pj1 = j; pr1 = rank; }
            if (bit && kk == 2u) { pj2 = j; pr2 = rank; } }
        if (lane < 32) cntw[wid * 32 + lane] = mycnt;
    }
    __syncthreads();
    if (wid == 0) {
        const int j = lane & 31; unsigned n = 0u;
        if (j < qb) n = cntw[j] + cntw[32 + j] + cntw[64 + j] + cntw[96 + j];
        const unsigned tl = (n + 31u) >> 5; unsigned excl = 0u, total = 0u;
#pragma unroll
        for (int k = 0; k < 32; ++k) { const unsigned v = (unsigned)__builtin_amdgcn_readlane((int)tl, k); excl += (k < j) ? v : 0u; total += v; }
        if (lane < 32) { startv[j] = 32u * excl; for (unsigned c = 0; c < tl; ++c) tiles[excl + c] = ((unsigned)j << 16) | (32u * (excl + c)); }
        if (lane == 0) misc[1] = total;
    }
    { LAS f32x4* bl = (LAS f32x4*)(lds + L_BIAS);
#pragma unroll
      for (int i = 0; i < 4; ++i) bl[tid + 512 * i] = bt[i]; }
    __syncthreads();
    if (wid < 4) {
        if (npick > 0) { unsigned base = startv[pj0]; for (int w = 0; w < wid; ++w) base += cntw[w * 32 + pj0]; list[base + pr0] = (unsigned short)((unsigned)tid); }
        if (npick > 1) { unsigned base = startv[pj1]; for (int w = 0; w < wid; ++w) base += cntw[w * 32 + pj1]; list[base + pr1] = (unsigned short)((unsigned)tid | (1u << 8)); }
        if (npick > 2) { unsigned base = startv[pj2]; for (int w = 0; w < wid; ++w) base += cntw[w * 32 + pj2]; list[base + pr2] = (unsigned short)((unsigned)tid | (2u << 8)); }
    }
    __syncthreads();
    const unsigned ntiles = misc[1];
    pair_stream(T, biasL, bh, q0, rowbase, lane, r32, hi, ntiles, misc, tiles, list, pl, lpl);
    const int oi = (wid < 4) ? wid : 11 - wid;
    u32x4 gpf[4];
    { const int le = launder(tidx()) & 63; const long or0 = rowbase + q0 + oi * 32;
#pragma unroll
      for (int i = 0; i < 4; ++i) gpf[i] = *(const u32x4*)(T.G + (or0 + i * 8 + (le >> 3)) * (long)T.gp + (le & 7) * 8); }
    SBAR();
    if (launder(tidx()) == 0) *qslot = __hip_atomic_fetch_add(qnext, 1u, __ATOMIC_RELAXED, __HIP_MEMORY_SCOPE_AGENT);
    f32x16 oo[2]; float lown;
    tile<true>(T, biasL, bh, qb, (oi >> 1) + 1, q0 + 32 * oi + r32, true, rowbase, lane, hi, oo, lown);
    __syncthreads();
    {
        f32x16 (&o)[2] = oo; float lsum = lown;
        { auto rr = __builtin_amdgcn_permlane32_swap(__float_as_uint(lsum), __float_as_uint(lsum), false, false); lsum = __uint_as_float(rr[0]) + __uint_as_float(rr[1]); }
        for (int k = 0; k < npick; ++k) lsum += lpl[k * 256 + 32 * oi + r32];
        for (int k = 0; k < npick; ++k) {
#pragma unroll
            for (int r = 0; r < 16; ++r) { const LAS bf16_t* src = pl + k * 16384 + (32 * oi + crow(r, hi)) * 64 + r32;
                o[0][r] += __builtin_bit_cast(float, (unsigned)src[0] << 16); o[1][r] += __builtin_bit_cast(float, (unsigned)src[32] << 16); }
        }
        LAS float* ltot = lpl + 3 * 256 - 256 + 0;
        (void)ltot;
        LAS float* lrow = (LAS float*)(lds + L_LIST) + 32 * oi;
        if (hi == 0) lrow[r32] = lsum;
        float rli[16];
#pragma unroll
        for (int r = 0; r < 16; ++r) rli[r] = 1.0f / lrow[crow(r, hi)];
        LAS bf16_t* stg = pl + (32 * oi) * 64;
#pragma unroll
        for (int r = 0; r < 16; ++r) { const int orow = crow(r, hi);
#pragma unroll
            for (int d0 = 0; d0 < 2; ++d0) stg[orow * 64 + d0 * 32 + r32] = (bf16_t)f2bf(o[d0][r] * rli[r]); }
        LDS_WAIT();
        const long orow0 = rowbase + q0 + oi * 32; const int lane_e = launder(tidx()) & 63;
#pragma unroll
        for (int i = 0; i < 4; ++i) { const int row = i * 8 + (lane_e >> 3), ch = lane_e & 7;
            const u32x4 ov = *(const LAS u32x4*)(stg + row * 64 + ch * 8);
            const u32x4 gv = gpf[i];
            u32x4 res;
#pragma unroll
            for (int e = 0; e < 4; ++e) { const float g0 = bflo(gv[e]), g1_ = bfhi(gv[e]);
                const float s0 = g0 / (1.0f + __expf(-g0)), s1 = g1_ / (1.0f + __expf(-g1_));
                res[e] = pk2(bflo(ov[e]) * s0, bfhi(ov[e]) * s1); }
            store16_wt(T.O + (orow0 + row) * (long)T.op + ch * 8, res); }
    }
    __syncthreads();
}
}

#define XB_TMO      128
#define XB_XCNT(j)  (256  + 64 * (j))
#define XB_XSUB(j)  (1280 + 64 * (j))
#define XB_XGEN(j)  (2304 + 64 * (j))
#define XB_TOP      3328
#define XB_TOPGEN   3392
#define XCD_BAR_WORDS 3456
#define XB_SPIN_CAP (1u << 18)
__device__ __forceinline__ unsigned xb_ld(unsigned* p)              { return __hip_atomic_load(p, __ATOMIC_RELAXED, __HIP_MEMORY_SCOPE_AGENT); }
__device__ __forceinline__ unsigned xb_add(unsigned* p, unsigned v) { return __hip_atomic_fetch_add(p, v, __ATOMIC_RELAXED, __HIP_MEMORY_SCOPE_AGENT); }
__device__ __forceinline__ unsigned xb_xcc_id() { return (unsigned)__builtin_amdgcn_s_getreg((3 << 11) | 20) & 0xFu; }
#define XB_SPIN(cond, bar) do { unsigned _sp = 0; while (cond) { __builtin_amdgcn_s_sleep(1); \
    if ((++_sp & 255u) == 0u) { if (xb_ld(&(bar)[XB_TMO])) break; if (_sp > XB_SPIN_CAP) { atomicAdd(&(bar)[XB_TMO], 1u); break; } } } } while (0)
struct XcdBarrier { unsigned* bar; unsigned x; volatile LAS unsigned* st; };
__device__ __forceinline__ XcdBarrier xcd_barrier_post(unsigned* bar, volatile LAS unsigned* st) {
    XcdBarrier b; b.bar = bar; b.x = xb_xcc_id(); b.st = st;
    if (threadIdx.x == 0) (void)xb_add(&bar[XB_XCNT(b.x)], 1u);
    return b;
}
__device__ __forceinline__ void xcd_barrier_complete(unsigned* bar, unsigned x, unsigned& nloc, unsigned& nx) {
    const unsigned G = gridDim.x * gridDim.y * gridDim.z;
    unsigned sum, cnt, mine, sp = 0u;
    for (;;) {
        sum = 0u; cnt = 0u; mine = 0u;
#pragma unroll
        for (unsigned j = 0; j < 16; ++j) { const unsigned c = xb_ld(&bar[XB_XCNT(j)]); sum += c; cnt += (c > 0u) ? 1u : 0u; }
        mine = xb_ld(&bar[XB_XCNT(x)]);
        if (sum == G) break;
        __builtin_amdgcn_s_sleep(1);
        if ((++sp & 255u) == 0u) { if (xb_ld(&bar[XB_TMO])) break; if (sp > XB_SPIN_CAP) { atomicAdd(&bar[XB_TMO], 1u); break; } }
    }
    nloc = mine > 0u ? mine : 1u; nx = cnt > 0u ? cnt : 1u;
}
__device__ __forceinline__ void xcd_barrier(const XcdBarrier& b) {
    asm volatile("s_waitcnt vmcnt(0)" ::: "memory");
    __syncthreads();
    if (tidx() == 0) {
        unsigned* bar = b.bar; asm volatile("" : "+s"(bar));
        __builtin_amdgcn_s_waitcnt(0);
        unsigned nloc = b.st[0], nx = b.st[1];
        if (nloc == 0u) { xcd_barrier_complete(bar, b.x, nloc, nx); b.st[0] = nloc; b.st[1] = nx; }
        const unsigned old = xb_add(&bar[XB_XSUB(b.x)], 1u);
        const unsigned gen = old / nloc;
        if (old + 1u == (gen + 1u) * nloc) {
            __builtin_amdgcn_fence(__ATOMIC_RELEASE, "agent");
            asm volatile("s_waitcnt vmcnt(0)" ::: "memory");
            const unsigned og = xb_add(&bar[XB_TOP], 1u);
            const unsigned tg = og / nx;
            if (og + 1u == (tg + 1u) * nx) xb_add(&bar[XB_TOPGEN], 1u);
            else XB_SPIN(xb_ld(&bar[XB_TOPGEN]) == tg, bar);
            __builtin_amdgcn_fence(__ATOMIC_ACQUIRE, "agent");
            xb_add(&bar[XB_XGEN(b.x)], 1u);
            asm volatile("s_waitcnt vmcnt(0)" ::: "memory");
        } else {
            XB_SPIN(xb_ld(&bar[XB_XGEN(b.x)]) == gen, bar);
            __builtin_amdgcn_fence(__ATOMIC_ACQUIRE, "agent");
            asm volatile("s_waitcnt vmcnt(0)" ::: "memory");
        }
    }
    __syncthreads();
}

constexpr int NWAVES = 8;
constexpr int RING_BYTES = 143360, LDSCTL_OFF = RING_BYTES, MISC_OFF = LDSCTL_OFF + 320, LDS_BYTES = 147456;
static_assert(att::L_END <= RING_BYTES && moba::L_END <= RING_BYTES && pg8::STAGE_BYTES <= RING_BYTES && WTAB_LDS == (unsigned)MISC_OFF + 128 && WTAB_LDS + 256 <= (unsigned)LDS_BYTES, "LDS map");

struct Args {
    const float* x; const float* c; const int* pos; const float* norm_g; const float* w_ada; const float* b_ada; const float* w_in;
    const float* q_norm_g; const float* w_uq; const float* kv_norm_g; const float* w_ukv; const float* q_g; const float* k_g;
    const float* mq_g; const float* mk_g; const float* w_out; const float* rel_bias;
    float* out; unsigned char* ws; int ph_lo, ph_hi;
};

__device__ __forceinline__ void transpose_item(const float* W, int K, int N, bf16_t* WT, int dstrow0, int k0, int n0, LAS float* scr, int lane) {
#pragma unroll 8
    for (int i = 0; i < 32; ++i) { const int kk = 2 * i + (lane >> 5); scr[kk * 33 + (lane & 31)] = W[(size_t)(k0 + kk) * N + n0 + (lane & 31)]; }
    LDS_WAIT(); asm volatile("" ::: "memory");
    const int c = lane & 7;
#pragma unroll
    for (int j = 0; j < 4; ++j) { const int n = (lane >> 3) + 8 * j; const LAS float* s = scr + (8 * c) * 33 + n;
        u32x4 o; o.x = pk2(s[0 * 33], s[1 * 33]); o.y = pk2(s[2 * 33], s[3 * 33]); o.z = pk2(s[4 * 33], s[5 * 33]); o.w = pk2(s[6 * 33], s[7 * 33]);
        *(u32x4*)(WT + (size_t)(dstrow0 + n) * K + k0 + 8 * c) = o; }
    LDS_WAIT(); asm volatile("" ::: "memory");
}

__global__ void __launch_bounds__(NWAVES * 64, 2) mk_fwd(Args A) {
    extern __shared__ __attribute__((aligned(16))) unsigned char lds_raw[];
    LAS unsigned char* lds = (LAS unsigned char*)lds_raw;
    volatile LAS unsigned* MISC = (volatile LAS unsigned*)(lds + MISC_OFF);
    const int tid = threadIdx.x, lane = tid & 63, wave = __builtin_amdgcn_readfirstlane(tid >> 6);
    const int G = gridDim.x, bx = blockIdx.x;
    const int vcu = (G % 8 == 0) ? (bx % 8) * (G / 8) + bx / 8 : bx;
    typedef __attribute__((address_space(4))) const Args* KArgsP;
    KArgsP kp0 = (KArgsP)__builtin_amdgcn_kernarg_segment_ptr();
    unsigned* ctl = (unsigned*)(A.ws + WS_CTL);
#define PH_ARGS KArgsP Ap = kp0; asm volatile("" : "+s"(Ap)); unsigned char* ws = Ap->ws; (void)ws; const int bx = launder_s32((int)blockIdx.x); (void)bx; \
    float* modb = (float*)(ws + WS_MOD); float* biasT = (float*)(ws + WS_BIAS); float* kpart = (float*)(ws + WS_KPART); float* ropeT = (float*)(ws + WS_ROPE); \
    bf16_t* Hb = (bf16_t*)(ws + WS_H); bf16_t* Zb = (bf16_t*)(ws + WS_Z); bf16_t* Qb = (bf16_t*)(ws + WS_Q); bf16_t* KVb = (bf16_t*)(ws + WS_KV); bf16_t* Kb = (bf16_t*)(ws + WS_K); \
    (void)modb; (void)biasT; (void)kpart; (void)ropeT; (void)Hb; (void)Zb; (void)Qb; (void)KVb; (void)Kb;
    for (int u = tid; u < (LDS_BYTES - LDSCTL_OFF) / 4; u += NWAVES * 64) ((LAS unsigned*)(lds + LDSCTL_OFF))[u] = 0u;
    __syncthreads();
    if ((threadIdx.x & 63) == 0) ((volatile LAS unsigned*)(size_t)WTAB_LDS)[hw_slot()] = threadIdx.x >> 6;
    __syncthreads();
    XcdBarrier bar; bar.bar = ctl + CW_BAR; bar.x = 0; bar.st = nullptr;
    if (MK_ONE_LAUNCH) bar = xcd_barrier_post(ctl + CW_BAR, MISC + 8);
    const int lo = A.ph_lo, hi_ = A.ph_hi;
#define IN(k) (lo <= (k) && (k) < hi_)
#define SEAM(k) do { if (IN(k) && IN((k) + 1)) xcd_barrier(bar); } while (0)

    if (IN(0)) { PH_ARGS const int tid = launder(tidx()), lane = tid & 63, wave = __builtin_amdgcn_readfirstlane(tid >> 6); (void)tid; (void)lane; (void)wave;
        if (bx < 96) {
            const int l = bx / 48, n0 = (bx % 48) * 64;
            LAS float* sc = (LAS float*)lds;
            for (int i = tid; i < 2 * DMODEL; i += 512) { const float v = Ap->c[i]; sc[i] = v / (1.0f + __expf(-v)); }
            __syncthreads();
            float a0 = 0.f, a1 = 0.f; const float* wp = Ap->w_ada + ((size_t)l * DMODEL + wave * 128) * 3072 + n0 + lane;
#pragma unroll 1
            for (int k0 = 0; k0 < 128; k0 += 32) { float wv[32];
#pragma unroll
                for (int k = 0; k < 32; ++k) wv[k] = wp[(size_t)(k0 + k) * 3072];
#pragma unroll
                for (int k = 0; k < 32; ++k) { a0 += sc[wave * 128 + k0 + k] * wv[k]; a1 += sc[DMODEL + wave * 128 + k0 + k] * wv[k]; } }
            LAS float* red = (LAS float*)(lds + 8192);
            red[(wave * 2 + 0) * 64 + lane] = a0; red[(wave * 2 + 1) * 64 + lane] = a1;
            __syncthreads();
            if (wave == 0) { float s0 = 0.f, s1 = 0.f;
#pragma unroll
                for (int w = 0; w < 8; ++w) { s0 += red[(w * 2 + 0) * 64 + lane]; s1 += red[(w * 2 + 1) * 64 + lane]; }
                const float bb = Ap->b_ada[l * 3072 + n0 + lane];
                modb[(l * 2 + 0) * 3072 + n0 + lane] = s0 + bb; modb[(l * 2 + 1) * 3072 + n0 + lane] = s1 + bb; }
            __syncthreads();
        }
        {
            LAS float* scr = (LAS float*)(lds + wave * 16384);
            const int gw = bx * NWAVES + wave, NGW = G * NWAVES;
            constexpr int I_IN = 16 * 93, I_OUT = 16 * 32, I_L = I_IN + I_OUT;
            constexpr int NFAST = (256 - 96) * NWAVES, NBULK = 3 * NFAST;
            static_assert(DEPTH * I_L - NBULK <= 96 * NWAVES && DEPTH * I_L >= NBULK, "P0 item split");
            const bool fastwg = (G == 256) && bx >= 96;
            const int it0 = (G != 256) ? gw : (fastwg ? gw - 96 * NWAVES : NBULK + gw), itstep = (G != 256) ? NGW : (fastwg ? NFAST : DEPTH * I_L), itend = (G != 256 || !fastwg) ? DEPTH * I_L : NBULK;
            for (int it = it0; it < itend; it += itstep) {
                const int l = it / I_L; int r = it % I_L; unsigned char* wl = ws + WS_W + (size_t)l * W_LAYER;
                if (r < I_IN) { const int kb = r / 93, nb = r % 93; transpose_item(Ap->w_in + (size_t)l * DMODEL * D_IN, DMODEL, D_IN, (bf16_t*)(wl + W_IN), (nb >= 13 ? 96 : 0) + nb * 32, kb * 64, nb * 32, scr, lane); continue; } r -= I_IN;
                { const int kb = r / 32, nb = r % 32; transpose_item(Ap->w_out + (size_t)l * DMODEL * DMODEL, DMODEL, DMODEL, (bf16_t*)(wl + W_OUT), nb * 32, kb * 64, nb * 32, scr, lane); }
            }
        }
        {
            const int gt = bx * 512 + tid, NT_ = G * 512;
            for (int i = gt; i < DEPTH * 96 * 128; i += NT_) { const int l = i / (96 * 128), r = i % (96 * 128);
                *(u32x4*)(ws + WS_W + (size_t)l * W_LAYER + W_IN + (size_t)416 * 2048 + (size_t)r * 16) = (u32x4){0u, 0u, 0u, 0u}; }
            for (int i = gt; i < DEPTH * 40960; i += NT_) { const int l = i / 40960, r = i % 40960; unsigned char* wl = ws + WS_W + (size_t)l * W_LAYER;
                const float* W; int N, n, k0; unsigned char* dst;
                if (r < 24576) { const int ln = r & 63; int q = r >> 6; const int nb = q % 3; q /= 3; const int ks = q & 15, h = q >> 4;
                    n = 96 * h + 32 * nb + (ln & 31); k0 = 16 * ks + 8 * (ln >> 5); W = Ap->w_uq + (size_t)l * QLORA * NQ; N = NQ; dst = wl + W_UQ + (size_t)r * 16; }
                else { const int r2 = r - 24576, ln = r2 & 63, q = r2 >> 6, nb = q & 1, ks = (q >> 1) & 7, h = (q >> 4) & 7, isv = q >> 7;
                    n = 128 * h + 64 * isv + 32 * nb + (ln & 31); k0 = 16 * ks + 8 * (ln >> 5); W = Ap->w_ukv + (size_t)l * KVLORA * NKV; N = NKV; dst = wl + W_UKV + (size_t)r2 * 16; }
                float f[8];
#pragma unroll
                for (int j = 0; j < 8; ++j) f[j] = W[(size_t)(k0 + j) * N + n];
                u32x4 o; o.x = pk2(f[0], f[1]); o.y = pk2(f[2], f[3]); o.z = pk2(f[4], f[5]); o.w = pk2(f[6], f[7]);
                *(u32x4*)dst = o; }
            for (int i = gt; i < M * 16; i += NT_) { const int row = i >> 4, j = i & 15;
                const float invf = powf(10000.0f, -(float)j / 16.0f); const float ang = (float)Ap->pos[row] * invf;
                float sn, cs; sincosf(ang, &sn, &cs); ropeT[row * 32 + j] = cs; ropeT[row * 32 + 16 + j] = sn; }
            for (int i = gt; i < 8 * 8192; i += NT_) { const int h = i >> 13, d = i & 8191;
                int bk; if (d < 16) bk = d; else { bk = 8 + (31 - __clz(d * d)); if (bk > 31) bk = 31; }
                biasT[i] = Ap->rel_bias[bk * 8 + h] * LOG2E; }
        }
    }
    SEAM(0);

#pragma unroll 1
    for (int l = 0; l < DEPTH; ++l) {
        const int P = 1 + 5 * l;
#define WL (ws + WS_W + (size_t)l * W_LAYER)
#define XIN ((l == 0) ? Ap->x : Ap->out)
        if (IN(P)) { PH_ARGS const int tid = launder(tidx()), lane = tid & 63, wave = __builtin_amdgcn_readfirstlane(tid >> 6); (void)tid; (void)lane; (void)wave;
            const int gw = bx * NWAVES + wave; const int b = (gw * 8) / SEQ;
            const float* mv = modb + (l * 2 + b) * 3072;
            f32x4 ga[4], sh[4];
#pragma unroll
            for (int j = 0; j < 4; ++j) { const int c0 = 4 * lane + 256 * j; const f32x4 g4 = *(const f32x4*)(Ap->norm_g + l * DMODEL + c0); const f32x4 s4 = *(const f32x4*)(mv + DMODEL + c0); ga[j] = g4 * (s4 + 1.0f); sh[j] = *(const f32x4*)(mv + c0); }
            for (int i0 = 0; i0 < 8; i0 += 4) {
                f32x4 v[4][4]; float ss[4];
#pragma unroll
                for (int u = 0; u < 4; ++u) { const size_t row = (size_t)gw * 8 + i0 + u; ss[u] = 0.f;
#pragma unroll
                    for (int j = 0; j < 4; ++j) { v[u][j] = *(const f32x4*)(XIN + row * DMODEL + 4 * lane + 256 * j); ss[u] += (v[u][j].x * v[u][j].x + v[u][j].y * v[u][j].y) + (v[u][j].z * v[u][j].z + v[u][j].w * v[u][j].w); } }
#pragma unroll
                for (int u = 0; u < 4; ++u) ss[u] = 1.0f / sqrtf(wave_sum(ss[u]) * (1.0f / DMODEL) + EPS);
#pragma unroll
                for (int u = 0; u < 4; ++u) { const size_t row = (size_t)gw * 8 + i0 + u;
#pragma unroll
                    for (int j = 0; j < 4; ++j) { const f32x4 hv = v[u][j] * ss[u] * ga[j] + sh[j]; u32x2 w; w.x = pk2(hv.x, hv.y); w.y = pk2(hv.z, hv.w); *(u32x2*)(Hb + row * DMODEL + 4 * lane + 256 * j) = w; } }
            }
        }
        SEAM(P);
        if (IN(P + 1)) { PH_ARGS
            pg8::Gemm g{Hb, (const bf16_t*)(WL + W_IN), M, ZP, DMODEL, DMODEL, DMODEL}; pg8::StaticOrder S; S.init(M, ZP, G, launder_s32(bx));
            pg8::EpiBf16 E{Zb, ZP};
            pg8::gemm_phase<pg8::EpiBf16>(lds, g, S, E);
        }
        SEAM(P + 1);
        if (IN(P + 2)) { PH_ARGS const int tid = launder(tidx()), lane = tid & 63, wave = __builtin_amdgcn_readfirstlane(tid >> 6); (void)tid; (void)lane; (void)wave;
            const int sub = lane & 7, r32 = lane & 31, hi = lane >> 5;
            constexpr int SROW = 1040;
            LAS unsigned char* stg = lds; LAS float* red = (LAS float*)(lds + 64 * SROW);
            constexpr int XQ_OFF = 64 * SROW + 16384, XQ_P = 528, XKV_OFF = XQ_OFF + 64 * XQ_P, XKV_P = 272, GQ_OFF = XKV_OFF + 64 * XKV_P, GK_OFF = GQ_OFF + 384, OST_W = 6656;
            static_assert(GK_OFF + 384 <= RING_BYTES && 8 * OST_W <= 64 * SROW, "phase C LDS map");
            if (tid < 96) { *(LAS float*)(lds + GQ_OFF + tid * 4) = Ap->q_g[l * 96 + tid]; *(LAS float*)(lds + GK_OFF + tid * 4) = Ap->k_g[l * 96 + tid]; }
            const int b = bx / 128, s0 = (bx % 128) * 64;
            bf16_t* KFb = (bf16_t*)(ws + WS_KF); bf16_t* VFb = (bf16_t*)(ws + WS_VF);
            u32x4 vrow[8];
#pragma unroll
            for (int i = 0; i < 8; ++i) vrow[i] = *(const u32x4*)(Zb + ((size_t)bx * 64 + wave * 8 + i) * ZP + ZC_VB + 8 * lane);
            const f32x4 rope_pf = *(const f32x4*)(ropeT + ((size_t)bx * 64 + (tid >> 3)) * 32 + (tid & 7) * 4);
            const u32x4 kr_pf = *(const u32x4*)(Zb + ((size_t)bx * 64 + ((tid & 255) >> 2)) * ZP + ZC_KROPE + (tid & 3) * 8);
            constexpr int ROPE_L = 64 * SROW, ROPE_P = 144, KR_L = ROPE_L + 64 * ROPE_P, KR_P = 80;
            static_assert(KR_L + 64 * KR_P <= 64 * SROW + 16384, "rope / k_rope LDS tables");
            float kacc[8];
#pragma unroll
            for (int e = 0; e < 8; ++e) kacc[e] = 0.f;
            f32x4 qng = *(const f32x4*)(Ap->q_norm_g + l * QLORA + 4 * lane); f32x2 kng = *(const f32x2*)(Ap->kv_norm_g + l * KVLORA + 2 * lane);
            float mqg[8], mkg[8];
#pragma unroll
            for (int e = 0; e < 8; ++e) { mqg[e] = Ap->mq_g[l * 64 + 8 * sub + e] * QSCALE_B; mkg[e] = Ap->mk_g[l * 64 + 8 * sub + e]; }
            for (int i0 = 0; i0 < 8; i0 += 4) {
                u32x2 cw[4]; unsigned dw[4]; u32x4 qw[4], kw[4]; float rq[4], rk[4];
#pragma unroll
                for (int u = 0; u < 4; ++u) { const bf16_t* zr = Zb + ((size_t)bx * 64 + wave * 8 + i0 + u) * ZP;
                    cw[u] = *(const u32x2*)(zr + ZC_CQ + 4 * lane); dw[u] = *(const unsigned*)(zr + ZC_CKV + 2 * lane); qw[u] = *(const u32x4*)(zr + ZC_QB + 8 * lane); kw[u] = *(const u32x4*)(zr + ZC_KB + 8 * lane); }
#pragma unroll
                for (int u = 0; u < 4; ++u) { const float a0 = bflo(cw[u].x), a1 = bfhi(cw[u].x), a2 = bflo(cw[u].y), a3 = bfhi(cw[u].y), c0 = bflo(dw[u]), c1 = bfhi(dw[u]);
                    rq[u] = (a0 * a0 + a1 * a1) + (a2 * a2 + a3 * a3); rk[u] = c0 * c0 + c1 * c1; }
#pragma unroll
                for (int u = 0; u < 4; ++u) { rq[u] = 1.0f / sqrtf(wave_sum(rq[u]) * (1.0f / QLORA) + EPS); rk[u] = 1.0f / sqrtf(wave_sum(rk[u]) * (1.0f / KVLORA) + EPS); }
#pragma unroll
                for (int u = 0; u < 4; ++u) { bf16_t* zr = Zb + ((size_t)bx * 64 + wave * 8 + i0 + u) * ZP;
                    { const float v0 = bflo(cw[u].x), v1 = bfhi(cw[u].x), v2 = bflo(cw[u].y), v3 = bfhi(cw[u].y);
                      u32x2 o; o.x = pk2(v0 * rq[u] * qng.x, v1 * rq[u] * qng.y); o.y = pk2(v2 * rq[u] * qng.z, v3 * rq[u] * qng.w); *(LAS u32x2*)(lds + XQ_OFF + (wave * 8 + i0 + u) * XQ_P + lane * 8) = o; }
                    { const float v0 = bflo(dw[u]), v1 = bfhi(dw[u]); *(LAS unsigned*)(lds + XKV_OFF + (wave * 8 + i0 + u) * XKV_P + lane * 4) = pk2(v0 * rk[u] * kng.x, v1 * rk[u] * kng.y); }
                    { float v[8]; float ss = 0.f;
#pragma unroll
                      for (int e = 0; e < 4; ++e) { v[2 * e] = bflo(qw[u][e]); v[2 * e + 1] = bfhi(qw[u][e]); ss += v[2 * e] * v[2 * e] + v[2 * e + 1] * v[2 * e + 1]; }
                      const float rstd = 1.0f / sqrtf(sum8(ss) * (1.0f / 64.0f) + EPS); u32x4 o;
#pragma unroll
                      for (int e = 0; e < 4; ++e) o[e] = pk2(v[2 * e] * rstd * mqg[2 * e], v[2 * e + 1] * rstd * mqg[2 * e + 1]);
                      *(u32x4*)(zr + ZC_QB + 8 * lane) = o; }
                    { float v[8]; float ss = 0.f;
#pragma unroll
                      for (int e = 0; e < 4; ++e) { v[2 * e] = bflo(kw[u][e]); v[2 * e + 1] = bfhi(kw[u][e]); ss += v[2 * e] * v[2 * e] + v[2 * e + 1] * v[2 * e + 1]; }
                      const float rstd = 1.0f / sqrtf(sum8(ss) * (1.0f / 64.0f) + EPS); u32x4 o;
#pragma unroll
                      for (int e = 0; e < 8; ++e) { v[e] = v[e] * rstd * mkg[e]; kacc[e] += v[e]; }
#pragma unroll
                      for (int e = 0; e < 4; ++e) o[e] = pk2(v[2 * e], v[2 * e + 1]);
                      *(LAS u32x4*)(stg + (wave * 8 + i0 + u) * SROW + lane * 16) = o; }
                }
            }
#pragma unroll
            for (int e = 0; e < 8; ++e) red[wave * 512 + lane * 8 + e] = kacc[e];
            __syncthreads();
            { float sm = 0.f;
#pragma unroll
              for (int w = 0; w < 8; ++w) sm += red[w * 512 + tid];
              kpart[(size_t)bx * 512 + tid] = sm; }
#pragma unroll
            for (int pi = 0; pi < 8; ++pi) { const int p = wave * 8 + pi, ktl = p >> 5, h = (p >> 2) & 7, d0 = p & 3;
                const u32x4 v = *(const LAS u32x4*)(stg + (32 * ktl + r32) * SROW + (h * 64 + d0 * 16 + hi * 8) * 2);
                const int kt = s0 / 32 + ktl;
                store16_wt(KFb + ((((size_t)(b * 8 + h) * 256 + kt) * 4 + d0) * 64 + lane) * 8, v); }
            __syncthreads();
#pragma unroll
            for (int i = 0; i < 8; ++i) *(LAS u32x4*)(stg + (wave * 8 + i) * SROW + lane * 16) = vrow[i];
            *(LAS f32x4*)(lds + ROPE_L + (tid >> 3) * ROPE_P + (tid & 7) * 16) = rope_pf;
            if (tid < 256) *(LAS u32x4*)(lds + KR_L + (tid >> 2) * KR_P + (tid & 3) * 16) = kr_pf;
            __syncthreads();
#pragma unroll
            for (int pi = 0; pi < 8; ++pi) { const int p = wave * 8 + pi, ksl = p >> 4, h = (p >> 1) & 7, dh = p & 1;
                const LAS unsigned char* cp = stg + (16 * ksl + 4 * hi) * SROW + (h * 64 + 32 * dh + r32) * 2;
                unsigned e[8];
#pragma unroll
                for (int j = 0; j < 8; ++j) e[j] = *(const LAS unsigned short*)(cp + ((j & 3) + 8 * (j >> 2)) * SROW);
                u32x4 w; w.x = e[0] | (e[1] << 16); w.y = e[2] | (e[3] << 16); w.z = e[4] | (e[5] << 16); w.w = e[6] | (e[7] << 16);
                const int ks = s0 / 16 + ksl;
                store16_wt(VFb + ((((size_t)(b * 8 + h) * 512 + ks) * 2 + dh) * 64 + lane) * 8, w); }
            __syncthreads();
            {
                const int h = wave, row0 = bx * 64;
                LAS unsigned char* ost = lds + wave * OST_W;
                const LAS unsigned char* xq = lds + XQ_OFF + r32 * XQ_P + hi * 16; const LAS unsigned char* xkv = lds + XKV_OFF + r32 * XKV_P + hi * 16;
                const LAS float* gqL = (const LAS float*)(lds + GQ_OFF); const LAS float* gkL = (const LAS float*)(lds + GK_OFF);
                const u32x4* wk = (const u32x4*)(WL + W_UKV) + (size_t)h * 1024 + lane; const u32x4* wv = (const u32x4*)(WL + W_UKV) + (size_t)(8 + h) * 1024 + lane;
                u32x4 ak[8][2], av[8][2];
                const LAS unsigned char* ropeL = lds + ROPE_L + r32 * ROPE_P; const LAS unsigned char* krL = lds + KR_L + r32 * KR_P;
                {
                    const u32x4* wq = (const u32x4*)(WL + W_UQ) + (size_t)h * 3072 + lane;
                    f32x16 acc[2][3];
#pragma unroll
                    for (int tb = 0; tb < 2; ++tb)
#pragma unroll
                        for (int nb = 0; nb < 3; ++nb) acc[tb][nb] = f32x16{};
                    u32x4 a[8][3];
#pragma unroll
                    for (int s_ = 0; s_ < 8; ++s_)
#pragma unroll
                        for (int nb = 0; nb < 3; ++nb) a[s_][nb] = wq[(s_ * 3 + nb) * 64];
                    SBAR();
#pragma unroll
                    for (int ks = 0; ks < 16; ++ks) {
                        bf16x8 bq[2];
#pragma unroll
                        for (int tb = 0; tb < 2; ++tb) bq[tb] = *(const LAS bf16x8*)(xq + tb * 32 * XQ_P + ks * 32);
#pragma unroll
                        for (int nb = 0; nb < 3; ++nb)
#pragma unroll
                            for (int tb = 0; tb < 2; ++tb) acc[tb][nb] = __builtin_amdgcn_mfma_f32_32x32x16_bf16(__builtin_bit_cast(bf16x8, a[ks & 7][nb]), bq[tb], acc[tb][nb], 0, 0, 0);
                        if (ks + 8 < 16) {
#pragma unroll
                            for (int nb = 0; nb < 3; ++nb) a[ks & 7][nb] = wq[((ks + 8) * 3 + nb) * 64]; }
                        SBAR();
                    }
#pragma unroll
                    for (int ks = 0; ks < 8; ++ks)
#pragma unroll
                        for (int nb = 0; nb < 2; ++nb) ak[ks][nb] = wk[(ks * 2 + nb) * 64];
                    SBAR();
#pragma unroll
                    for (int tb = 0; tb < 2; ++tb) {
                        const size_t row = (size_t)row0 + tb * 32 + r32;
                        float ss = 0.f;
#pragma unroll
                        for (int nb = 0; nb < 3; ++nb)
#pragma unroll
                            for (int r = 0; r < 16; ++r) ss += acc[tb][nb][r] * acc[tb][nb][r];
                        { auto rr = __builtin_amdgcn_permlane32_swap(__float_as_uint(ss), __float_as_uint(ss), false, false); ss = __uint_as_float(rr[0]) + __uint_as_float(rr[1]); }
                        const float rstd = QSCALE_A / sqrtf(ss * (1.0f / 96.0f) + EPS);
#pragma unroll
                        for (int nb = 0; nb < 2; ++nb)
#pragma unroll
                            for (int i = 0; i < 4; ++i) { const int n0 = nb * 32 + 8 * i + 4 * hi; const f32x4 g4 = *(const LAS f32x4*)(gqL + n0);
                                u32x2 o; o.x = pk2(acc[tb][nb][4 * i] * rstd * g4.x, acc[tb][nb][4 * i + 1] * rstd * g4.y); o.y = pk2(acc[tb][nb][4 * i + 2] * rstd * g4.z, acc[tb][nb][4 * i + 3] * rstd * g4.w);
                                *(LAS u32x2*)(ost + r32 * 208 + n0 * 2) = o; }
#pragma unroll
                        for (int i = 0; i < 2; ++i) { const int f0 = 8 * i + 4 * hi;
                            const f32x4 cs = *(const LAS f32x4*)(ropeL + tb * 32 * ROPE_P + f0 * 4), sn = *(const LAS f32x4*)(ropeL + tb * 32 * ROPE_P + 64 + f0 * 4);
                            const f32x4 g1 = *(const LAS f32x4*)(gqL + 64 + f0), g2 = *(const LAS f32x4*)(gqL + 80 + f0);
                            float o1[4], o2[4];
#pragma unroll
                            for (int j = 0; j < 4; ++j) { const float x1 = acc[tb][2][4 * i + j] * rstd * g1[j], x2 = acc[tb][2][4 * (i + 2) + j] * rstd * g2[j];
                                o1[j] = x1 * cs[j] - x2 * sn[j]; o2[j] = x1 * sn[j] + x2 * cs[j]; }
                            u32x2 w1, w2; w1.x = pk2(o1[0], o1[1]); w1.y = pk2(o1[2], o1[3]); w2.x = pk2(o2[0], o2[1]); w2.y = pk2(o2[2], o2[3]);
                            *(LAS u32x2*)(ost + r32 * 208 + (64 + f0) * 2) = w1; *(LAS u32x2*)(ost + r32 * 208 + (80 + f0) * 2) = w2; }
                        LDS_WAIT();
#pragma unroll
                        for (int k = 0; k < 6; ++k) { const int idx = lane + 64 * k, t = idx / 12, c = idx % 12;
                            const u32x4 v = *(const LAS u32x4*)(ost + t * 208 + c * 16);
                            *(u32x4*)(Qb + ((size_t)row0 + tb * 32 + t) * NQ + 96 * h + 8 * c) = v; }
                        LDS_WAIT();
                    }
                }
                {
                    f32x16 acc[2][2];
#pragma unroll
                    for (int tb = 0; tb < 2; ++tb)
#pragma unroll
                        for (int nb = 0; nb < 2; ++nb) acc[tb][nb] = f32x16{};
#pragma unroll
                    for (int ks = 0; ks < 8; ++ks) {
                        bf16x8 bq[2];
#pragma unroll
                        for (int tb = 0; tb < 2; ++tb) bq[tb] = *(const LAS bf16x8*)(xkv + tb * 32 * XKV_P + ks * 32);
#pragma unroll
                        for (int nb = 0; nb < 2; ++nb)
#pragma unroll
                            for (int tb = 0; tb < 2; ++tb) acc[tb][nb] = __builtin_amdgcn_mfma_f32_32x32x16_bf16(__builtin_bit_cast(bf16x8, ak[ks][nb]), bq[tb], acc[tb][nb], 0, 0, 0);
                    }
#pragma unroll
                    for (int ks = 0; ks < 8; ++ks)
#pragma unroll
                        for (int nb = 0; nb < 2; ++nb) av[ks][nb] = wv[(ks * 2 + nb) * 64];
                    SBAR();
#pragma unroll
                    for (int tb = 0; tb < 2; ++tb) {
                        const u32x4 kr1 = *(const LAS u32x4*)(krL + tb * 32 * KR_P + 16 * hi), kr2 = *(const LAS u32x4*)(krL + tb * 32 * KR_P + 32 + 16 * hi);
                        float x1[8], x2[8]; float ss = 0.f;
#pragma unroll
                        for (int e = 0; e < 4; ++e) { x1[2 * e] = bflo(kr1[e]); x1[2 * e + 1] = bfhi(kr1[e]); x2[2 * e] = bflo(kr2[e]); x2[2 * e + 1] = bfhi(kr2[e]); }
#pragma unroll
                        for (int e = 0; e < 8; ++e) ss += x1[e] * x1[e] + x2[e] * x2[e];
#pragma unroll
                        for (int nb = 0; nb < 2; ++nb)
#pragma unroll
                            for (int r = 0; r < 16; ++r) ss += acc[tb][nb][r] * acc[tb][nb][r];
                        { auto rr = __builtin_amdgcn_permlane32_swap(__float_as_uint(ss), __float_as_uint(ss), false, false); ss = __uint_as_float(rr[0]) + __uint_as_float(rr[1]); }
                        const float rstd = 1.0f / sqrtf(ss * (1.0f / 96.0f) + EPS);
#pragma unroll
                        for (int nb = 0; nb < 2; ++nb)
#pragma unroll
                            for (int i = 0; i < 4; ++i) { const int n0 = nb * 32 + 8 * i + 4 * hi; const f32x4 g4 = *(const LAS f32x4*)(gkL + n0);
                                u32x2 o; o.x = pk2(acc[tb][nb][4 * i] * rstd * g4.x, acc[tb][nb][4 * i + 1] * rstd * g4.y); o.y = pk2(acc[tb][nb][4 * i + 2] * rstd * g4.z, acc[tb][nb][4 * i + 3] * rstd * g4.w);
                                *(LAS u32x2*)(ost + r32 * 208 + n0 * 2) = o; }
                        { float o1[8], o2[8];
#pragma unroll
                          for (int q4 = 0; q4 < 2; ++q4) { const int f0 = 8 * hi + 4 * q4;
                              const f32x4 cs = *(const LAS f32x4*)(ropeL + tb * 32 * ROPE_P + f0 * 4), sn = *(const LAS f32x4*)(ropeL + tb * 32 * ROPE_P + 64 + f0 * 4);
                              const f32x4 g1 = *(const LAS f32x4*)(gkL + 64 + f0), g2 = *(const LAS f32x4*)(gkL + 80 + f0);
#pragma unroll
                              for (int j = 0; j < 4; ++j) { const float y1 = x1[4 * q4 + j] * rstd * g1[j], y2 = x2[4 * q4 + j] * rstd * g2[j];
                                  o1[4 * q4 + j] = y1 * cs[j] - y2 * sn[j]; o2[4 * q4 + j] = y1 * sn[j] + y2 * cs[j]; } }
                          u32x4 w1, w2;
#pragma unroll
                          for (int e = 0; e < 4; ++e) { w1[e] = pk2(o1[2 * e], o1[2 * e + 1]); w2[e] = pk2(o2[2 * e], o2[2 * e + 1]); }
                          *(LAS u32x4*)(ost + r32 * 208 + (64 + 8 * hi) * 2) = w1; *(LAS u32x4*)(ost + r32 * 208 + (80 + 8 * hi) * 2) = w2; }
                        LDS_WAIT();
#pragma unroll
                        for (int k = 0; k < 6; ++k) { const int idx = lane + 64 * k, t = idx / 12, c = idx % 12;
                            const u32x4 v = *(const LAS u32x4*)(ost + t * 208 + c * 16);
                            *(u32x4*)(Kb + ((size_t)row0 + tb * 32 + t) * NQ + 96 * h + 8 * c) = v; }
                        LDS_WAIT();
                    }
                }
                {
                    f32x16 acc[2][2];
#pragma unroll
                    for (int tb = 0; tb < 2; ++tb)
#pragma unroll
                        for (int nb = 0; nb < 2; ++nb) acc[tb][nb] = f32x16{};
#pragma unroll
                    for (int ks = 0; ks < 8; ++ks) {
                        bf16x8 bq[2];
#pragma unroll
                        for (int tb = 0; tb < 2; ++tb) bq[tb] = *(const LAS bf16x8*)(xkv + tb * 32 * XKV_P + ks * 32);
#pragma unroll
                        for (int nb = 0; nb < 2; ++nb)
#pragma unroll
                            for (int tb = 0; tb < 2; ++tb) acc[tb][nb] = __builtin_amdgcn_mfma_f32_32x32x16_bf16(__builtin_bit_cast(bf16x8, av[ks][nb]), bq[tb], acc[tb][nb], 0, 0, 0);
                    }
#pragma unroll
                    for (int tb = 0; tb < 2; ++tb) {
#pragma unroll
                        for (int nb = 0; nb < 2; ++nb)
#pragma unroll
                            for (int i = 0; i < 4; ++i) { const int n0 = nb * 32 + 8 * i + 4 * hi;
                                u32x2 o; o.x = pk2(acc[tb][nb][4 * i], acc[tb][nb][4 * i + 1]); o.y = pk2(acc[tb][nb][4 * i + 2], acc[tb][nb][4 * i + 3]);
                                *(LAS u32x2*)(ost + r32 * 144 + n0 * 2) = o; }
                        LDS_WAIT();
#pragma unroll
                        for (int k = 0; k < 4; ++k) { const int idx = lane + 64 * k, t = idx >> 3, c = idx & 7;
                            const u32x4 v = *(const LAS u32x4*)(ost + t * 144 + c * 16);
                            *(u32x4*)(KVb + ((size_t)row0 + tb * 32 + t) * NKV + 128 * h + 64 + 8 * c) = v; }
                        LDS_WAIT();
                    }
                }
            }
            __syncthreads();
        }
        SEAM(P + 2);
        if (IN(P + 3)) { PH_ARGS const int tid = launder(tidx()), lane = tid & 63; (void)lane;
            float gq = fabsf(Ap->mq_g[l * 64 + lane]), gk = fabsf(Ap->mk_g[l * 64 + lane]), bm = 0.f;
            const int xg = bx & 7;
#pragma unroll
            for (int o_ = 1; o_ < 32; o_ <<= 1) { gq = fmaxf(gq, swz_xor_dyn(gq, o_)); gk = fmaxf(gk, swz_xor_dyn(gk, o_)); }
            { auto rr = __builtin_amdgcn_permlane32_swap(__float_as_uint(gq), __float_as_uint(gq), false, false); gq = fmaxf(__uint_as_float(rr[0]), __uint_as_float(rr[1])); }
            { auto rr = __builtin_amdgcn_permlane32_swap(__float_as_uint(gk), __float_as_uint(gk), false, false); gk = fmaxf(__uint_as_float(rr[0]), __uint_as_float(rr[1])); }
            const float gqk = __builtin_bit_cast(float, __builtin_amdgcn_readfirstlane(__builtin_bit_cast(int, 8.0f * gq * gk)));
            unsigned* qctr = ctl + CW_Q + (l * 8 + xg) * 64;
            if (tidx() == 0) MISC[16] = __hip_atomic_fetch_add(qctr, 1u, __ATOMIC_RELAXED, __HIP_MEMORY_SCOPE_AGENT);
            for (;;) {
                __syncthreads();
                const unsigned ui = MISC[16];
                __syncthreads();
                if (ui >= 128u) break;
                const int type = (int)(ui >> 6), r = (int)(ui & 63u), qb = 31 - (r >> 1), bh = 2 * xg + (r & 1), b = bh >> 3, h = bh & 7;
                if (type == 0) { att::Tens T{Qb + 96 * h, NQ, Kb + 96 * h, NQ, KVb + 128 * h + 64, NKV, Zb + ZC_GMLA + 64 * h, ZP, Zb + ZC_AO + 64 * h, ZP, 0.f};
                    att::unit<6>(T, b, qb, (LAS char*)lds, qctr, MISC + 16); }
                else {
                    bm = 0.f; { const int ln = launder(tidx()) & 31; const float v = fabsf(Ap->rel_bias[ln * 8 + h]); bm = v;
#pragma unroll
                      for (int o_ = 1; o_ < 32; o_ <<= 1) bm = fmaxf(bm, swz_xor_dyn(bm, o_));
                      auto rr = __builtin_amdgcn_permlane32_swap(__float_as_uint(bm), __float_as_uint(bm), false, false); bm = fmaxf(__uint_as_float(rr[0]), __uint_as_float(rr[1])); }
                    const float Bshift = fminf((gqk + bm) * LOG2E, 40.0f);
                    moba::Tens T{Zb + ZC_QB + 64 * h, ZP, Zb + ZC_GMOBA + 64 * h, ZP, Zb + ZC_AO + 512 + 64 * h, ZP, kpart, biasT + h * 8192, (const bf16_t*)(ws + WS_KF), (const bf16_t*)(ws + WS_VF), Bshift};
                    moba::unit(T, b, h, qb, (LAS char*)lds, qctr, MISC + 16); }
            }
        }
        SEAM(P + 3);
        if (IN(P + 4)) { PH_ARGS
            pg8::Gemm g{Zb + ZC_AO, (const bf16_t*)(WL + W_OUT), M, DMODEL, DMODEL, ZP, DMODEL}; pg8::StaticOrder S; S.init(M, DMODEL, G, launder_s32(bx));
            pg8::EpiResid E{XIN, Ap->out, DMODEL, modb + (l * 2) * 3072 + 2 * DMODEL, 3072};
            pg8::gemm_phase<pg8::EpiResid>(lds, g, S, E);
        }
        if (l + 1 < DEPTH) SEAM(P + 4);
    }
#undef IN
#undef SEAM
}

constexpr int N_PHASES = 1 + 5 * DEPTH;

extern "C" void kernel_launch(void* const* d_in, const int* in_sizes, int n_in, void* d_out, int out_size, void* d_ws, size_t ws_size, hipStream_t stream) {
    static int ready = 0, one_launch = 0;
    if (ready == 0) {
        if (n_in != 17 || in_sizes[0] != M * DMODEL || out_size != M * DMODEL || ws_size < WS_END) { fprintf(stderr, "kernel_launch: unexpected shapes (n_in %d, in0 %d, out %d, ws %zu)\n", n_in, n_in > 0 ? in_sizes[0] : -1, out_size, ws_size); ready = -1; return; }
        if (hipFuncSetAttribute((const void*)mk_fwd, hipFuncAttributeMaxDynamicSharedMemorySize, LDS_BYTES) != hipSuccess) { fprintf(stderr, "kernel_launch: hipFuncSetAttribute failed\n"); ready = -1; return; }
        int dev = 0, cus = 0, per_cu = 0;
        if (hipGetDevice(&dev) != hipSuccess || hipDeviceGetAttribute(&cus, hipDeviceAttributeMultiprocessorCount, dev) != hipSuccess) cus = 0;
        if (hipOccupancyMaxActiveBlocksPerMultiprocessor(&per_cu, (const void*)mk_fwd, NWAVES * 64, LDS_BYTES) != hipSuccess) per_cu = 0;
        (void)hipGetLastError();
        one_launch = (MK_ONE_LAUNCH && (long)cus * (long)per_cu >= 256) ? 1 : 0;
        if (!one_launch) fprintf(stderr, "kernel_launch: %d CUs x %d resident workgroups < 256: falling back to one launch per phase\n", cus, per_cu);
        ready = 1;
    }
    if (ready < 0) return;
    (void)hipMemsetAsync((char*)d_ws + WS_CTL, 0, CTL_ZERO_BYTES, stream);
    Args a{};
    a.x = (const float*)d_in[0]; a.c = (const float*)d_in[1]; a.pos = (const int*)d_in[2]; a.norm_g = (const float*)d_in[3]; a.w_ada = (const float*)d_in[4]; a.b_ada = (const float*)d_in[5];
    a.w_in = (const float*)d_in[6]; a.q_norm_g = (const float*)d_in[7]; a.w_uq = (const float*)d_in[8]; a.kv_norm_g = (const float*)d_in[9]; a.w_ukv = (const float*)d_in[10];
    a.q_g = (const float*)d_in[11]; a.k_g = (const float*)d_in[12]; a.mq_g = (const float*)d_in[13]; a.mk_g = (const float*)d_in[14]; a.w_out = (const float*)d_in[15]; a.rel_bias = (const float*)d_in[16];
    a.out = (float*)d_out; a.ws = (unsigned char*)d_ws;
    const int grid = 256;
    if (one_launch) { a.ph_lo = 0; a.ph_hi = N_PHASES; hipLaunchKernelGGL(mk_fwd, dim3(grid), dim3(NWAVES * 64), LDS_BYTES, stream, a); }
    else for (int p = 0; p < N_PHASES; ++p) { a.ph_lo = p; a.ph_hi = p + 1; hipLaunchKernelGGL(mk_fwd, dim3(grid), dim3(NWAVES * 64), LDS_BYTES, stream, a); }
}
```

```cpp
#include <hip/hip_runtime.h>
#include <hip/hip_bf16.h>
#include <cstdio>
#include <cstdint>
#include <cmath>

#ifndef MK_ONE_LAUNCH
#define MK_ONE_LAUNCH 1
#endif

#define LAS __attribute__((address_space(3)))
#define GAS __attribute__((address_space(1)))
typedef unsigned short bf16_t;
typedef short bf16x8 __attribute__((ext_vector_type(8)));
typedef short s16x4 __attribute__((ext_vector_type(4)));
typedef float f32x4 __attribute__((ext_vector_type(4)));
typedef float f32x2 __attribute__((ext_vector_type(2)));
typedef float f32x16 __attribute__((ext_vector_type(16)));
typedef unsigned u32x4 __attribute__((ext_vector_type(4)));
typedef unsigned u32x2 __attribute__((ext_vector_type(2)));

constexpr int BATCH = 2, SEQ = 8192, DMODEL = 1024, DEPTH = 2;
constexpr int M = BATCH * SEQ;
constexpr int D_IN = 2976, ZP = 3072;
constexpr int ZC_CQ = 0, ZC_CKV = 256, ZC_KROPE = 384, ZC_GMLA = 512, ZC_QB = 1024, ZC_KB = 1536, ZC_VB = 2048, ZC_GMOBA = 2560;
constexpr int QLORA = 256, KVLORA = 128, NQ = 768, NKV = 1024;
constexpr float EPS = 1e-6f;
constexpr float LOG2E = 1.4426950408889634f;
constexpr float QSCALE_A = 0.10206207261596577f * LOG2E;
constexpr float QSCALE_B = 0.125f * LOG2E;

constexpr size_t MiB = 1u << 20;
constexpr size_t WS_CTL = 0, CTL_ZERO_BYTES = 1 * MiB;
constexpr size_t WS_W = 2 * MiB, W_LAYER = 10 * MiB;
constexpr size_t W_IN = 0, W_OUT = 6 * MiB, W_UQ = 8 * MiB, W_UKV = 9 * MiB;
constexpr size_t WS_MOD = 22 * MiB;
constexpr size_t WS_BIAS = 22 * MiB + 64 * 1024;
constexpr size_t WS_KPART = 22 * MiB + 512 * 1024;
constexpr size_t WS_ROPE = 24 * MiB;
constexpr size_t WS_H = 26 * MiB;
constexpr size_t WS_Z = 58 * MiB;
constexpr size_t WS_Q = 154 * MiB;
constexpr size_t WS_KV = 178 * MiB;
constexpr size_t WS_K = 210 * MiB;
constexpr size_t WS_KF = WS_H, WS_VF = WS_H + 16 * MiB;
constexpr size_t WS_END = 234 * MiB;
constexpr int CW_BAR = 4096, CW_Q = 16384;
constexpr int ZC_AO = 1536;

__device__ __forceinline__ unsigned f2bf(float f) { unsigned u = __builtin_bit_cast(unsigned, f); return (u + 0x7fffu + ((u >> 16) & 1u)) >> 16; }
__device__ __forceinline__ unsigned pk2(float lo, float hi) { typedef __bf16 bf16x2_t __attribute__((ext_vector_type(2))); f32x2 v = {lo, hi}; return __builtin_bit_cast(unsigned, __builtin_convertvector(v, bf16x2_t)); }
__device__ __forceinline__ float bflo(unsigned w) { return __builtin_bit_cast(float, w << 16); }
__device__ __forceinline__ float bfhi(unsigned w) { return __builtin_bit_cast(float, w & 0xffff0000u); }
template <int X> __device__ __forceinline__ float swz_xor(float v) { return __builtin_bit_cast(float, __builtin_amdgcn_ds_swizzle(__builtin_bit_cast(int, v), (X << 10) | 0x1f)); }
__device__ __forceinline__ float swz_xor_dyn(float v, int x) {
    switch (x) { case 1: return swz_xor<1>(v); case 2: return swz_xor<2>(v); case 4: return swz_xor<4>(v); case 8: return swz_xor<8>(v); default: return swz_xor<16>(v); } }
__device__ __forceinline__ float sum8(float v) { v += swz_xor<1>(v); v += swz_xor<2>(v); v += swz_xor<4>(v); return v; }
__device__ __forceinline__ float wave_sum(float v) {
    v = sum8(v); v += swz_xor<8>(v); v += swz_xor<16>(v);
    auto rr = __builtin_amdgcn_permlane32_swap(__builtin_bit_cast(unsigned, v), __builtin_bit_cast(unsigned, v), false, false);
    return __builtin_bit_cast(float, rr[0]) + __builtin_bit_cast(float, rr[1]);
}
__device__ __forceinline__ const void* launder_s(const void* p) { asm volatile("" : "+s"(p)); return p; }
constexpr unsigned WTAB_LDS = 143360 + 320 + 128;
__device__ __forceinline__ int hw_slot() { return (int)(__builtin_amdgcn_s_getreg((5 << 11) | 4) & 63u); }
__device__ __forceinline__ int tidx() {
    const unsigned w = ((volatile LAS unsigned*)(size_t)WTAB_LDS)[hw_slot()];
    int lane_; asm volatile("v_mbcnt_lo_u32_b32 %0, -1, 0\n\tv_mbcnt_hi_u32_b32 %0, -1, %0" : "=v"(lane_));
    return (int)((unsigned)__builtin_amdgcn_readfirstlane((int)w) << 6) | lane_;
}
template <class V> __device__ __forceinline__ void store16_wt(void* p, V v) { static_assert(sizeof(V) == 16, "16-byte payload");
    asm volatile("global_store_dwordx4 %0, %1, off sc1\n\ts_nop 1" :: "v"(p), "v"(v) : "memory"); }
__device__ __forceinline__ int launder_s32(int v) { asm volatile("" : "+s"(v)); return v; }
__device__ __forceinline__ int launder(int v) { asm volatile("" : "+v"(v)); return v; }
#define LDS_WAIT() asm volatile("s_waitcnt lgkmcnt(0)" ::: "memory")
#define VM_WAIT() asm volatile("s_waitcnt vmcnt(0)" ::: "memory")

namespace pg8 {
constexpr int BM = 256, BK = 64, HALF = 128, HTB = HALF * BK * 2, STAGE_BYTES = 8 * HTB, NXCD = 8, WGM = 8;
__host__ __device__ __forceinline__ int lds_byte(int r, int c) { const int st = (r >> 4) * 2 + (c >> 5), rr = r & 15, cc = c & 31, ob = rr * 64 + cc * 2; return st * 1024 + (ob ^ (((ob >> 9) & 1) << 5)); }
__host__ __device__ __forceinline__ void stage_rc(int b, int& R, int& C) { const int st = b / 1024, sb = b % 1024, swz = sb ^ (((sb >> 9) & 1) << 5); R = (st >> 1) * 16 + swz / 64; C = (st & 1) * 32 + (swz % 64) / 2; }
__host__ __device__ __forceinline__ int perm32(int rho) { const int n = rho >> 4, i = rho & 15; return 8 * (i >> 2) + 4 * n + (i & 3); }
struct Unit { int pm, pn; };
struct Gemm { const bf16_t* A; const bf16_t* Bt; int M, N, K, lda, ldb; };
struct StaticOrder {
    int nM, nN, nwg, G, c;
    __device__ void init(int M_, int N_, int G_, int c_) { nM = M_ / BM; nN = N_ / BM; nwg = nM * nN; G = G_; c = c_; }
    __device__ bool next(int i, Unit& u) const {
        const long L = (long)i * G + c; if (L >= nwg) return false;
        int wgid = (int)L; { const int q = nwg / NXCD, r = nwg % NXCD, xcd = wgid % NXCD, off = wgid / NXCD; wgid = (xcd < r ? xcd * (q + 1) : r * (q + 1) + (xcd - r) * q) + off; }
        const int nig = WGM * nN, gid = wgid / nig, fm = gid * WGM, gsz = (nM - fm) < WGM ? (nM - fm) : WGM;
        u.pm = fm + ((wgid % nig) % gsz); u.pn = (wgid % nig) / gsz; return true;
    }
};
__device__ __forceinline__ unsigned cvt_pk_bf16(float lo, float hi) { unsigned r; asm volatile("v_cvt_pk_bf16_f32 %0, %1, %2" : "=v"(r) : "v"(lo), "v"(hi)); return r; }

struct EpiBf16 {
    static constexpr bool PERM = true;
    bf16_t* O; int ldc;
    __device__ __forceinline__ void operator()(const f32x4 (&acc)[2][2][4][2], const Unit& u, int wr, int wc, int fr, int fq) const {
        const int row0 = u.pm * BM + wr * 64 + fr; const int col0 = u.pn * BM + wc * 32 + 8 * fq;
#pragma unroll
        for (int ai = 0; ai < 2; ++ai)
#pragma unroll
            for (int m = 0; m < 4; ++m) { bf16_t* rowp = O + (size_t)(row0 + ai * HALF + m * 16) * ldc + col0;
#pragma unroll
                for (int bj = 0; bj < 2; ++bj) { const f32x4 v0 = acc[ai][bj][m][0], v1 = acc[ai][bj][m][1];
                    u32x4 w; w.x = cvt_pk_bf16(v0[0], v0[1]); w.y = cvt_pk_bf16(v0[2], v0[3]); w.z = cvt_pk_bf16(v1[0], v1[1]); w.w = cvt_pk_bf16(v1[2], v1[3]);
                    store16_wt(rowp + bj * HALF, w); } }
    }
};
struct EpiResid {
    static constexpr bool PERM = false;
    const float* xin; float* out; int ldc; const float* gate0; int gstride;
    __device__ __forceinline__ void operator()(const f32x4 (&acc)[2][2][4][2], const Unit& u, int wr, int wc, int fr, int fq) const {
        const int col0 = u.pn * BM + wc * 32 + 4 * fq; const float* gate = gate0 + (size_t)((u.pm * BM) / SEQ) * gstride;
        f32x4 gv[2][2];
#pragma unroll
        for (int bj = 0; bj < 2; ++bj)
#pragma unroll
            for (int n = 0; n < 2; ++n) gv[bj][n] = *(const f32x4*)(gate + col0 + bj * HALF + n * 16);
#pragma unroll
        for (int ai = 0; ai < 2; ++ai) {
            f32x4 xi[4][2][2];
#pragma unroll
            for (int m = 0; m < 4; ++m) { const size_t off = (size_t)(u.pm * BM + ai * HALF + wr * 64 + m * 16 + fr) * ldc + col0;
#pragma unroll
                for (int bj = 0; bj < 2; ++bj)
#pragma unroll
                    for (int n = 0; n < 2; ++n) xi[m][bj][n] = *(const f32x4*)(xin + off + bj * HALF + n * 16); }
#pragma unroll
            for (int m = 0; m < 4; ++m) { const size_t off = (size_t)(u.pm * BM + ai * HALF + wr * 64 + m * 16 + fr) * ldc + col0;
#pragma unroll
                for (int bj = 0; bj < 2; ++bj)
#pragma unroll
                    for (int n = 0; n < 2; ++n) { const f32x4 ov = xi[m][bj][n] + gv[bj][n] * acc[ai][bj][m][n]; store16_wt(out + off + bj * HALF + n * 16, ov); } }
        }
    }
};

template <class Epi, bool ALIGN_EPI = true>
__device__ __forceinline__ void gemm_phase(LAS unsigned char* lds, const Gemm g, const StaticOrder& S, const Epi& E) {
    const int tid = launder(tidx()), wid = __builtin_amdgcn_readfirstlane(tid >> 6), lane = tid & 63, wr = wid >> 2, wc = wid & 3, fr = lane & 15, fq = lane >> 4;
    const int K = g.K, nt = K / BK;
    unsigned voffA[2], voffB[2];
#pragma unroll
    for (int i = 0; i < 2; ++i) { int R, C; stage_rc(tid * 16 + i * 8192, R, C); const int Rb = Epi::PERM ? ((R & ~31) + perm32(R & 31)) : R;
        voffA[i] = (unsigned)(R * g.lda + C) * 2u; voffB[i] = (unsigned)(Rb * g.ldb + C) * 2u; }
    const size_t kstep = (size_t)(BK * 2);
    const size_t hstepA = (size_t)HALF * g.lda * 2, hstepB = (size_t)HALF * g.ldb * 2;
    const size_t tstepA = 2 * hstepA, tstepB = 2 * hstepB;
    const unsigned ldsw = (unsigned)wid * 1024u;
    const int aoff = lds_byte(wr * 64 + fr, fq * 8), boff = lds_byte(wc * 32 + fr, fq * 8);
#define PG8_SA(b, h) (((b) * 2 + (h)) * HTB)
#define PG8_SB(b, h) ((4 + (b) * 2 + (h)) * HTB)
#define PG8_STAGE(bufoff, gbase, voff) do { _Pragma("unroll") for (int _i = 0; _i < 2; ++_i) \
        __builtin_amdgcn_global_load_lds((const unsigned*)((const char*)(gbase) + (voff)[_i]), (LAS unsigned*)(lds + (bufoff) + ldsw + _i * 8192), 16, 0, 0); } while (0)
#define PG8_LDA(dst, b, h) do { _Pragma("unroll") for (int m = 0; m < 4; ++m) _Pragma("unroll") for (int k = 0; k < 2; ++k) dst[m][k] = *(const LAS bf16x8*)(lds + PG8_SA(b, h) + aoff + m * 2048 + k * 1024); } while (0)
#define PG8_LDB(dst, b, h) do { _Pragma("unroll") for (int n = 0; n < 2; ++n) _Pragma("unroll") for (int k = 0; k < 2; ++k) dst[n][k] = *(const LAS bf16x8*)(lds + PG8_SB(b, h) + boff + n * 2048 + k * 1024); } while (0)
#define PG8_MMA(ai, bj, At, Bt) do { __builtin_amdgcn_s_setprio(1); _Pragma("unroll") for (int m = 0; m < 4; ++m) _Pragma("unroll") for (int n = 0; n < 2; ++n) _Pragma("unroll") for (int k = 0; k < 2; ++k) \
        acc[ai][bj][m][n] = __builtin_amdgcn_mfma_f32_16x16x32_bf16(Bt[n][k], At[m][k], acc[ai][bj][m][n], 0, 0, 0); __builtin_amdgcn_s_setprio(0); } while (0)
#define PG8_WAIT_V(n) asm volatile("s_waitcnt vmcnt(" #n ")" ::: "memory")
#define PG8_WAIT_L(n) asm volatile("s_waitcnt lgkmcnt(" #n ")" ::: "memory")
#define PG8_BAR __builtin_amdgcn_s_barrier()
#define PG8_SCHED __builtin_amdgcn_sched_barrier(0)
    Unit cur, nxt; int ui = 0;
    if (!S.next(0, cur)) return;
    f32x4 acc[2][2][4][2];
#pragma unroll
    for (int a = 0; a < 2; ++a)
#pragma unroll
        for (int b = 0; b < 2; ++b)
#pragma unroll
            for (int m = 0; m < 4; ++m)
#pragma unroll
                for (int n = 0; n < 2; ++n) acc[a][b][m][n] = (f32x4){0.f, 0.f, 0.f, 0.f};
    bf16x8 At[4][2], B0[2][2], B1[2][2];
    const char* cA = (const char*)g.A + (size_t)cur.pm * tstepA; const char* cB = (const char*)g.Bt + (size_t)cur.pn * tstepB;
    {
        PG8_STAGE(PG8_SB(0, 0), cB, voffB); PG8_STAGE(PG8_SB(0, 1), cB + hstepB, voffB); PG8_STAGE(PG8_SA(0, 0), cA, voffA); PG8_STAGE(PG8_SA(0, 1), cA + hstepA, voffA);
        if (wr == 1) PG8_BAR;
        PG8_WAIT_V(2); PG8_BAR;
        PG8_STAGE(PG8_SB(1, 0), cB + kstep, voffB); PG8_STAGE(PG8_SA(1, 0), cA + kstep, voffA); PG8_STAGE(PG8_SB(1, 1), cB + hstepB + kstep, voffB);
        PG8_WAIT_V(6); PG8_BAR;
    }
    for (;;) {
        const bool has_next = S.next(ui + 1, nxt);
        const char* nA = has_next ? (const char*)g.A + (size_t)nxt.pm * tstepA : cA; const char* nB = has_next ? (const char*)g.Bt + (size_t)nxt.pn * tstepB : cB;
        for (int t = 0; t < nt; t += 2) {
            const bool last = (t == nt - 2);
            const char* a1 = cA + (size_t)(t + 1) * kstep;
            const char* a2 = last ? nA : cA + (size_t)(t + 2) * kstep; const char* b2 = last ? nB : cB + (size_t)(t + 2) * kstep;
            const char* a3 = a2 + kstep; const char* b3 = b2 + kstep;
            PG8_LDB(B0, 0, 0); PG8_LDB(B1, 0, 1); PG8_SCHED; PG8_LDA(At, 0, 0); PG8_STAGE(PG8_SA(1, 1), a1 + hstepA, voffA);
            PG8_WAIT_V(8); PG8_WAIT_L(0); PG8_BAR; PG8_MMA(0, 0, At, B0); PG8_MMA(0, 1, At, B1); PG8_BAR; PG8_SCHED;
            PG8_LDA(At, 0, 1); PG8_STAGE(PG8_SB(0, 0), b2, voffB); PG8_STAGE(PG8_SB(0, 1), b2 + hstepB, voffB); PG8_STAGE(PG8_SA(0, 0), a2, voffA);
            PG8_WAIT_V(8); PG8_WAIT_L(0); PG8_BAR; PG8_MMA(1, 0, At, B0); PG8_MMA(1, 1, At, B1); PG8_BAR; PG8_SCHED;
            PG8_LDB(B0, 1, 0); PG8_LDB(B1, 1, 1); PG8_SCHED; PG8_LDA(At, 1, 0); PG8_STAGE(PG8_SA(0, 1), a2 + hstepA, voffA);
            PG8_WAIT_V(8); PG8_WAIT_L(0); PG8_BAR; PG8_MMA(0, 0, At, B0); PG8_MMA(0, 1, At, B1); PG8_BAR; PG8_SCHED;
            PG8_LDA(At, 1, 1); PG8_STAGE(PG8_SB(1, 0), b3, voffB); PG8_STAGE(PG8_SB(1, 1), b3 + hstepB, voffB); PG8_STAGE(PG8_SA(1, 0), a3, voffA);
            PG8_WAIT_V(8); PG8_WAIT_L(0); PG8_BAR; PG8_MMA(1, 0, At, B0); PG8_MMA(1, 1, At, B1); PG8_BAR; PG8_SCHED;
        }
        if constexpr (ALIGN_EPI) { if (wr == 0) PG8_BAR; }
        { const int l2 = launder(tidx()) & 63; E(acc, cur, wr, wc, l2 & 15, l2 >> 4); }
        if (!has_next) break;
#pragma unroll
        for (int a = 0; a < 2; ++a)
#pragma unroll
            for (int b = 0; b < 2; ++b)
#pragma unroll
                for (int m = 0; m < 4; ++m)
#pragma unroll
                    for (int n = 0; n < 2; ++n) acc[a][b][m][n] = (f32x4){0.f, 0.f, 0.f, 0.f};
        cur = nxt; cA = nA; cB = nB; ++ui;
        if constexpr (ALIGN_EPI) { if (wr == 1) PG8_BAR; }
    }
    PG8_WAIT_V(0);
    if constexpr (!ALIGN_EPI) { if (wr == 0) PG8_BAR; }
    PG8_BAR;
#undef PG8_SA
#undef PG8_SB
#undef PG8_STAGE
#undef PG8_LDA
#undef PG8_LDB
#undef PG8_MMA
#undef PG8_WAIT_V
#undef PG8_WAIT_L
#undef PG8_BAR
#undef PG8_SCHED
}
}

namespace att {
constexpr int SLOT = 20480, KOFF = 0, VOFF = 12288;
constexpr int L_WSF = 4 * SLOT, L_OST = L_WSF + 2048, L_END = L_OST + 8 * 4096;
constexpr float THR = 8.f;
__device__ __forceinline__ int crow(int r, int hi) { return (r & 3) + 8 * (r >> 2) + 4 * hi; }
__device__ __forceinline__ void glds16(const void* gsrc, unsigned lds_dst) { unsigned keep;
    asm volatile("s_mov_b32 %0, m0\n\ts_mov_b32 m0, %2\n\ts_nop 0\n\tglobal_load_lds_dwordx4 %1, off\n\ts_mov_b32 m0, %0" : "=&s"(keep) : "v"(gsrc), "s"(lds_dst) : "memory"); }
__device__ __forceinline__ void glds16s(const void* sbase, unsigned voff, unsigned lds_dst) { unsigned keep;
    asm volatile("s_mov_b32 %0, m0\n\ts_mov_b32 m0, %3\n\ts_nop 0\n\tglobal_load_lds_dwordx4 %1, %2\n\ts_mov_b32 m0, %0" : "=&s"(keep) : "v"(voff), "s"(sbase), "s"(lds_dst) : "memory"); }
__device__ __forceinline__ unsigned cvtpk_s(float lo, float hi) { typedef __bf16 bf16x2_t __attribute__((ext_vector_type(2))); f32x2 v = {lo, hi}; bf16x2_t b = __builtin_convertvector(v, bf16x2_t); return __builtin_bit_cast(unsigned, b); }
typedef short v4i16_t __attribute__((ext_vector_type(4)));
__device__ __forceinline__ s16x4 vtr(const LAS char* p) { return __builtin_bit_cast(s16x4, __builtin_amdgcn_ds_read_tr16_b64_v4i16((LAS v4i16_t*)p)); }
#define ATT_WAIT_BAR() asm volatile("s_waitcnt vmcnt(0) lgkmcnt(0)\n\ts_barrier" ::: "memory")
#define MX3(a, b, c) __builtin_fmaxf(__builtin_fmaxf((a), (b)), (c))
#define SBAR() __builtin_amdgcn_sched_barrier(0)
__device__ __forceinline__ int bucket(int d) { if (d < 16) return d; const int b = 39 - __builtin_clz((unsigned)(d * d)); return b > 31 ? 31 : b; }

struct Tens { const bf16_t* Q; int qp; const bf16_t* K; int kp; const bf16_t* V; int vp; const bf16_t* G; int gp; bf16_t* O; int op; float Bshift; };

template <int NKD>
__device__ __forceinline__ void unit(const Tens& T, int b, int qb, LAS char* lds, unsigned* qnext, volatile LAS unsigned* qslot) {
    const int tid = launder(tidx()), lane = tid & 63, r32 = lane & 31, hi = lane >> 5; const int wid = __builtin_amdgcn_readfirstlane(tid >> 6);
    const bool g1 = wid >= 4;
    const long rowbase = (long)b * SEQ; const int q0 = qb * 256, NT = 4 * qb + 4;
    const int qpos = q0 + wid * 32 + r32;
    const unsigned lds0 = (unsigned)(uintptr_t)lds;
    LAS float* wsf = (LAS float*)(lds + L_WSF) + wid * 64;
    static_assert(NKD == 6, "the counted vmcnt below assumes 5 LDS-DMA pieces per wave and tile");
    const int w4 = wid & 3;
    const unsigned koff = (unsigned)((lane * T.kp + w4 * 8) * 2);
    const unsigned voff = (unsigned)(((16 * w4 + (lane >> 2)) * T.vp + (lane & 3) * 8) * 2);
    auto dmaK = [&](int t) {
        const unsigned kd = (unsigned)__builtin_amdgcn_readfirstlane((int)(lds0 + (t & 3) * SLOT + KOFF + w4 * 1024));
        const bf16_t* kb_ = T.K + (rowbase + (long)t * 64) * (long)T.kp;
        glds16s(kb_, koff, kd); glds16s(kb_ + 32, koff, kd + 4096); glds16s(kb_ + 64, koff, kd + 8192);
    };
    auto dmaV = [&](int t) {
        const unsigned vd = (unsigned)__builtin_amdgcn_readfirstlane((int)(lds0 + (t & 3) * SLOT + VOFF + w4 * 1024));
        const bf16_t* vb_ = T.V + (rowbase + (long)t * 64) * (long)T.vp;
        glds16s(vb_, voff, vd); glds16s(vb_ + 32, voff, vd + 4096);
    };
    if (g1) { dmaK(0); dmaK(1); } else { dmaV(0); dmaV(1); }
    bf16x8 qr[NKD];
    { const bf16_t* Qw = T.Q + (rowbase + qpos) * (long)T.qp;
#pragma unroll
      for (int d0 = 0; d0 < NKD; ++d0) qr[d0] = *(const bf16x8*)(Qw + d0 * 16 + hi * 8); }
    float l_reg = 0.f; f32x16 o[2]; o[0] = f32x16{}; o[1] = f32x16{};
    unsigned nx_ = 0u;
    const LAS char* vp0 = lds + VOFF + ((lane >> 4) & 1) * 32 + (lane & 3) * 8 + (4 * hi + ((lane & 15) >> 2)) * 64;
    const LAS char* kp0 = lds + KOFF + hi * 1024 + r32 * 16;
#pragma unroll
    for (int d0 = 0; d0 < NKD; ++d0) asm volatile("" : "+v"(qr[d0]));
    f32x16 p0 = f32x16{}, p1 = f32x16{}; u32x4 pw[4]; bool pend = false;
    s16x4 vlo[4], vhh[4];
#pragma unroll
    for (int i = 0; i < 4; ++i) pw[i] = (u32x4){0u, 0u, 0u, 0u};
#pragma unroll
    for (int i = 0; i < 4; ++i) { vlo[i] = s16x4{}; vhh[i] = s16x4{}; }
    auto tile_act = [&](int t) -> bool { const int jb = t - (NT - 4); return (jb < 0) || (2 * jb <= wid); };
    auto pre = [&](int t, bool rk, bool rv) {
        if (rv) { const LAS char* vb = vp0 + ((t - 1) & 3) * SLOT;
#pragma unroll
            for (int i = 0; i < 4; ++i) { vlo[i] = vtr(vb + i * 1024); vhh[i] = vtr(vb + i * 1024 + 512); } }
        (void)rk;
    };
    auto pv = [&](int tv) {
        const LAS char* vb = vp0 + (tv & 3) * SLOT + 4096; s16x4 wlo[4], whh[4];
#pragma unroll
        for (int i = 0; i < 4; ++i) { wlo[i] = vtr(vb + i * 1024); whh[i] = vtr(vb + i * 1024 + 512); }
        SBAR();
#pragma unroll
        for (int ks = 0; ks < 4; ++ks) { const bf16x8 vf = (bf16x8){vlo[ks][0], vlo[ks][1], vlo[ks][2], vlo[ks][3], vhh[ks][0], vhh[ks][1], vhh[ks][2], vhh[ks][3]};
            o[0] = __builtin_amdgcn_mfma_f32_32x32x16_bf16(__builtin_bit_cast(bf16x8, pw[ks]), vf, o[0], 0, 0, 0); }
#pragma unroll
        for (int ks = 0; ks < 4; ++ks) { const bf16x8 vf = (bf16x8){wlo[ks][0], wlo[ks][1], wlo[ks][2], wlo[ks][3], whh[ks][0], whh[ks][1], whh[ks][2], whh[ks][3]};
            o[1] = __builtin_amdgcn_mfma_f32_32x32x16_bf16(__builtin_bit_cast(bf16x8, pw[ks]), vf, o[1], 0, 0, 0); }
    };
    auto qk = [&](const bf16x8 (&kf)[2 * NKD]) {
        p0 = f32x16{}; p1 = f32x16{};
#pragma unroll
        for (int d0 = 0; d0 < NKD; ++d0) {
            p0 = __builtin_amdgcn_mfma_f32_32x32x16_bf16(kf[2 * d0], qr[d0], p0, 0, 0, 0);
            p1 = __builtin_amdgcn_mfma_f32_32x32x16_bf16(kf[2 * d0 + 1], qr[d0], p1, 0, 0, 0); }
    };
    auto h1 = [&](int t, bool full) {
        const bool aq = full || tile_act(t);
        if (aq) { const LAS char* kb = kp0 + (t & 3) * SLOT; bf16x8 kf[2 * NKD];
#pragma unroll
            for (int d0 = 0; d0 < NKD; ++d0) { kf[2 * d0] = *(const LAS bf16x8*)(kb + d0 * 2048); kf[2 * d0 + 1] = *(const LAS bf16x8*)(kb + d0 * 2048 + 512); }
            if (full || pend) pv(t - 1);
            qk(kf);
        } else if (pend) pv(t - 1);
        pend = false; };
    auto h2 = [&](int t, bool full) {
        if (!full && !tile_act(t)) return;
        const int jb = full ? -1 : t - (NT - 4);
        if (jb >= 0) { const int lb = launder(tidx()) & 63, qposb = q0 + wid * 32 + (lb & 31); const int kbase = 64 * t + 4 * (lb >> 5);
#pragma unroll
            for (int r = 0; r < 16; ++r) { const int kv = kbase + (r & 3) + 8 * (r >> 2); if (kv > qposb) p0[r] = -INFINITY; if (kv + 32 > qposb) p1[r] = -INFINITY; } }
        float sacc = 0.f;
#pragma unroll
        for (int r = 0; r < 16; ++r) { p0[r] = __builtin_amdgcn_exp2f(p0[r]); p1[r] = __builtin_amdgcn_exp2f(p1[r]); sacc += p0[r] + p1[r]; }
        l_reg += sacc;
#pragma unroll
        for (int i = 0; i < 4; ++i) { pw[0][i] = cvtpk_s(p0[2 * i], p0[2 * i + 1]); pw[1][i] = cvtpk_s(p0[8 + 2 * i], p0[8 + 2 * i + 1]); pw[2][i] = cvtpk_s(p1[2 * i], p1[2 * i + 1]); pw[3][i] = cvtpk_s(p1[8 + 2 * i], p1[8 + 2 * i + 1]); }
        pend = true;
    };
    auto fin = [&]() {
        u32x4 gpf[4];
        { const int le = launder(tidx()) & 63; const long or0 = rowbase + q0 + wid * 32;
#pragma unroll
          for (int i = 0; i < 4; ++i) gpf[i] = *(const u32x4*)(T.G + (or0 + i * 8 + (le >> 3)) * (long)T.gp + (le & 7) * 8); }
        SBAR();
        if (pend) pv(NT - 1);
        pend = false;
        if (launder(tidx()) == 0) *qslot = nx_;
        { auto rr = __builtin_amdgcn_permlane32_swap(__float_as_uint(l_reg), __float_as_uint(l_reg), false, false); l_reg = __uint_as_float(rr[0]) + __uint_as_float(rr[1]); }
        const int lf = launder(tidx()) & 63, r32f = lf & 31, hif = lf >> 5;
        if (hif == 0) wsf[32 + r32f] = l_reg;
        float rli[16];
#pragma unroll
        for (int r = 0; r < 16; ++r) rli[r] = 1.0f / wsf[32 + crow(r, hif)];
        LAS bf16_t* stg = (LAS bf16_t*)(lds + L_OST) + wid * 2048;
#pragma unroll
        for (int r = 0; r < 16; ++r) { const int orow = crow(r, hif);
#pragma unroll
            for (int d0 = 0; d0 < 2; ++d0) stg[orow * 64 + d0 * 32 + r32f] = (bf16_t)f2bf(o[d0][r] * rli[r]); }
        LDS_WAIT();
        const long orow0 = rowbase + q0 + wid * 32; const int lane_e = launder(tidx()) & 63;
#pragma unroll
        for (int i = 0; i < 4; ++i) { const int row = i * 8 + (lane_e >> 3), ch = lane_e & 7;
            const u32x4 ov = *(const LAS u32x4*)(stg + row * 64 + ch * 8);
            const u32x4 gv = gpf[i];
            u32x4 res;
#pragma unroll
            for (int e = 0; e < 4; ++e) { const float g0 = bflo(gv[e]), g1_ = bfhi(gv[e]);
                const float s0 = g0 / (1.0f + __expf(-g0)), s1 = g1_ / (1.0f + __expf(-g1_));
                res[e] = pk2(bflo(ov[e]) * s0, bfhi(ov[e]) * s1); }
            store16_wt(T.O + (orow0 + row) * (long)T.op + ch * 8, res); }
    };
#define ATT_BE() asm volatile("s_waitcnt lgkmcnt(0)\n\ts_barrier" ::: "memory")
#define ATT_BO5() asm volatile("s_waitcnt vmcnt(3) lgkmcnt(0)\n\ts_barrier" ::: "memory")
#define ATT_BO0() asm volatile("s_waitcnt vmcnt(0) lgkmcnt(0)\n\ts_barrier" ::: "memory")
    asm volatile("s_waitcnt vmcnt(0) lgkmcnt(0)\n\ts_barrier" ::: "memory");
    if (!g1) {
        pre(0, true, false);
        ATT_BE(); h1(0, false); ATT_BO0(); dmaV(2); pre(1, tile_act(1), tile_act(0)); h2(0, NT > 4);
        int t = 1;
        for (; t < NT - 4; ++t) { ATT_BE(); h1(t, true); ATT_BO0(); dmaV(t + 2); pre(t + 1, true, true); h2(t, true); }
        const int tf = t;
        for (; t < NT; ++t) { ATT_BE(); h1(t, false); ATT_BO0(); if (t == tf && launder(tidx()) == 0) nx_ = __hip_atomic_fetch_add(qnext, 1u, __ATOMIC_RELAXED, __HIP_MEMORY_SCOPE_AGENT); if (t + 2 < NT) dmaV(t + 2); pre(t + 1, (t + 1 < NT) && tile_act(t + 1), tile_act(t)); h2(t, false); }
        ATT_BE(); fin(); ATT_BO0();
    } else {
        ATT_BE(); dmaK(2); pre(0, true, false); ATT_BO5(); h1(0, false);
        int t = 1;
        for (; t < NT - 4; ++t) { ATT_BE(); dmaK(t + 2); pre(t, true, true); h2(t - 1, true); ATT_BO5(); h1(t, true); }
        for (; t < NT; ++t) { ATT_BE(); const bool more = t + 2 < NT; if (more) dmaK(t + 2); pre(t, tile_act(t), tile_act(t - 1)); h2(t - 1, t - 1 < NT - 4); if (more) ATT_BO5(); else ATT_BO0(); h1(t, false); }
        ATT_BE(); pre(NT, false, tile_act(NT - 1)); h2(NT - 1, false); ATT_BO0(); fin();
    }
#undef ATT_BE
#undef ATT_BO5
#undef ATT_BO0
    asm volatile("s_waitcnt lgkmcnt(0)\n\ts_barrier" ::: "memory");
}
}


namespace moba {
constexpr int L_PL = 0, L_LPL = 98304, L_BIAS = L_LPL + 3072, L_LIST = L_BIAS + 32768, LIST_N = 1792, L_TILES = L_LIST + LIST_N * 2, L_CNT = L_TILES + 256, L_START = L_CNT + 512, L_MISC = L_START + 128, L_END = L_MISC + 64;
using att::crow; using att::cvtpk_s; using att::bucket;
struct Tens { const bf16_t* Q; int qp; const bf16_t* G; int gp; bf16_t* O; int op; const float* kpart; const float* bias; const bf16_t* KF; const bf16_t* VF; float Bshift; };

template <bool OWN>
__device__ __forceinline__ void tile(const Tens& T, const LAS float* biasL, int bh, int j, int nst, int qpos, bool valid, long rowbase, int lane, int hi, f32x16 (&o)[2], float& lsum) {
    bf16x8 qr[4];
    { const bf16_t* Qw = T.Q + (rowbase + qpos) * (long)T.qp;
#pragma unroll
      for (int d0 = 0; d0 < 4; ++d0) qr[d0] = *(const bf16x8*)(Qw + d0 * 16 + hi * 8); }
    o[0] = f32x16{}; o[1] = f32x16{}; lsum = 0.f;
    const bf16_t* kfp = T.KF + (((size_t)bh * 256 + (size_t)j * 8) * 4 * 64 + lane) * 8;
    const bf16_t* vfp = T.VF + (((size_t)bh * 512 + (size_t)j * 16) * 2 * 64 + lane) * 8;
    bf16x8 kf[8], vf[8];
#pragma unroll
    for (int d0 = 0; d0 < 4; ++d0) { kf[2 * d0] = *(const bf16x8*)(kfp + (0 * 4 + d0) * 512); kf[2 * d0 + 1] = *(const bf16x8*)(kfp + (1 * 4 + d0) * 512); }
#pragma unroll
    for (int k = 0; k < 4; ++k) { vf[k] = *(const bf16x8*)(vfp + ((size_t)k * 2 + 0) * 512); vf[4 + k] = *(const bf16x8*)(vfp + ((size_t)k * 2 + 1) * 512); }
    f32x16 p0, p1; float cm; u32x4 pw[4];
    auto qk_bias = [&](int st) {
        const int sn = (st + 1 < nst) ? st + 1 : st;
        p0 = f32x16{}; p1 = f32x16{};
#pragma unroll
        for (int d0 = 0; d0 < 4; ++d0) {
            p0 = __builtin_amdgcn_mfma_f32_32x32x16_bf16(kf[2 * d0], qr[d0], p0, 0, 0, 0);
            p1 = __builtin_amdgcn_mfma_f32_32x32x16_bf16(kf[2 * d0 + 1], qr[d0], p1, 0, 0, 0); }
#pragma unroll
        for (int d0 = 0; d0 < 4; ++d0) { kf[2 * d0] = *(const bf16x8*)(kfp + ((size_t)(2 * sn) * 4 + d0) * 512); kf[2 * d0 + 1] = *(const bf16x8*)(kfp + ((size_t)(2 * sn + 1) * 4 + d0) * 512); }
        const int keybase = 256 * j + 64 * st, kb4 = keybase + 4 * hi;
        if (!OWN || st + 1 < nst) {
            const int dmin = qpos - keybase - 63, dmax = qpos - keybase;
            const bool uni = bucket(dmin) == bucket(dmax);
            float c = 0.f;
            if (__all(uni)) c = biasL[dmin];
            else {
                const LAS float* bp = biasL + (qpos - kb4 - 59);
#pragma unroll
                for (int r = 0; r < 16; ++r) { const int cr = (r & 3) + 8 * (r >> 2); p0[r] += bp[59 - cr]; p1[r] += bp[59 - cr - 32]; }
            }
            cm = valid ? (c - T.Bshift) : -INFINITY;
        } else {
#pragma unroll
            for (int r = 0; r < 16; ++r) { const int kv = kb4 + (r & 3) + 8 * (r >> 2); const int d0_ = qpos - kv, d1_ = d0_ - 32;
                const float b0 = biasL[__builtin_elementwise_max(d0_, 0)], b1 = biasL[__builtin_elementwise_max(d1_, 0)];
                p0[r] = (d0_ >= 0) ? p0[r] + b0 : -INFINITY; p1[r] = (d1_ >= 0) ? p1[r] + b1 : -INFINITY; }
            cm = -T.Bshift;
        }
    };
    auto pack = [&]() {
#pragma unroll
        for (int i = 0; i < 4; ++i) { pw[0][i] = cvtpk_s(p0[2 * i], p0[2 * i + 1]); pw[1][i] = cvtpk_s(p0[8 + 2 * i], p0[8 + 2 * i + 1]); pw[2][i] = cvtpk_s(p1[2 * i], p1[2 * i + 1]); pw[3][i] = cvtpk_s(p1[8 + 2 * i], p1[8 + 2 * i + 1]); }
    };
    qk_bias(0);
    { float sacc = 0.f;
#pragma unroll
      for (int r = 0; r < 16; ++r) { p0[r] = __builtin_amdgcn_exp2f(p0[r] + cm); p1[r] = __builtin_amdgcn_exp2f(p1[r] + cm); sacc += p0[r] + p1[r]; }
      lsum += sacc; }
    pack();
#pragma unroll 1
    for (int st = 1; st < nst; ++st) {
        qk_bias(st);
        float sacc = 0.f;
#pragma unroll
        for (int g = 0; g < 8; ++g) {
            o[g >> 2] = __builtin_amdgcn_mfma_f32_32x32x16_bf16(__builtin_bit_cast(bf16x8, pw[g & 3]), vf[g], o[g >> 2], 0, 0, 0);
#pragma unroll
            for (int e = 0; e < 2; ++e) { const int r = 2 * g + e; p0[r] = __builtin_amdgcn_exp2f(p0[r] + cm); p1[r] = __builtin_amdgcn_exp2f(p1[r] + cm); sacc += p0[r] + p1[r]; }
        }
        lsum += sacc;
#pragma unroll
        for (int k = 0; k < 4; ++k) { vf[k] = *(const bf16x8*)(vfp + ((size_t)(4 * st + k) * 2 + 0) * 512); vf[4 + k] = *(const bf16x8*)(vfp + ((size_t)(4 * st + k) * 2 + 1) * 512); }
        pack();
    }
#pragma unroll
    for (int g = 0; g < 8; ++g) o[g >> 2] = __builtin_amdgcn_mfma_f32_32x32x16_bf16(__builtin_bit_cast(bf16x8, pw[g & 3]), vf[g], o[g >> 2], 0, 0, 0);
}

__device__ __forceinline__ void pair_stream(const Tens& T, const LAS float* biasL, int bh, int q0, long rowbase, int lane, int r32, int hi, unsigned ntiles,
                                            LAS unsigned* misc, const LAS unsigned* tiles, const LAS unsigned short* list, LAS bf16_t* pl, LAS float* lpl) {
    auto fetch = [&]() -> unsigned { unsigned ti = 0u; if (lane == 0) ti = __hip_atomic_fetch_add(misc, 1u, __ATOMIC_RELAXED, __HIP_MEMORY_SCOPE_WORKGROUP); return (unsigned)__builtin_amdgcn_readfirstlane((int)ti); };
    unsigned ti = fetch();
    if (ti >= ntiles) return;
    unsigned te = tiles[ti]; int off = (int)(te & 0xffffu), j = (int)(te >> 16);
    unsigned v16 = list[off + r32]; bool valid = v16 != 0xFFFFu; int qpos = q0 + (valid ? (int)(v16 & 255u) : 0);
    bf16x8 qr[4], qn[4], kf[8], vf[8];
    { const bf16_t* Qw = T.Q + (rowbase + qpos) * (long)T.qp;
#pragma unroll
      for (int d0 = 0; d0 < 4; ++d0) qr[d0] = *(const bf16x8*)(Qw + d0 * 16 + hi * 8); }
    const bf16_t* kfp = T.KF + (((size_t)bh * 256 + (size_t)j * 8) * 4 * 64 + lane) * 8;
    const bf16_t* vfp = T.VF + (((size_t)bh * 512 + (size_t)j * 16) * 2 * 64 + lane) * 8;
#pragma unroll
    for (int d0 = 0; d0 < 4; ++d0) { kf[2 * d0] = *(const bf16x8*)(kfp + (0 * 4 + d0) * 512); kf[2 * d0 + 1] = *(const bf16x8*)(kfp + (1 * 4 + d0) * 512); }
#pragma unroll
    for (int k = 0; k < 4; ++k) { vf[k] = *(const bf16x8*)(vfp + ((size_t)k * 2 + 0) * 512); vf[4 + k] = *(const bf16x8*)(vfp + ((size_t)k * 2 + 1) * 512); }
#pragma unroll
    for (int d0 = 0; d0 < 4; ++d0) qn[d0] = qr[d0];
#pragma unroll 1
    for (;;) {
        unsigned tn = ti; bool hn = false; int offn = off, jn = j; unsigned v16n = v16; bool validn = valid; int qposn = qpos; const bf16_t* kfn = kfp;
        f32x16 o[2]; o[0] = f32x16{}; o[1] = f32x16{}; float lsum = 0.f;
        f32x16 p0, p1; u32x4 pw[4];
        auto qk_bias = [&](int st) {
            const int keybase = 256 * j + 64 * st, kb4 = keybase + 4 * hi;
            const int dmin = qpos - keybase - 63, dmax = qpos - keybase;
            const bool allu = __all(bucket(dmin) == bucket(dmax));
            const float cinit = valid ? ((allu ? biasL[dmin] : 0.f) - T.Bshift) : -INFINITY;
            f32x16 ci;
#pragma unroll
            for (int r = 0; r < 16; ++r) ci[r] = cinit;
            p0 = __builtin_amdgcn_mfma_f32_32x32x16_bf16(kf[0], qr[0], ci, 0, 0, 0);
            p1 = __builtin_amdgcn_mfma_f32_32x32x16_bf16(kf[1], qr[0], ci, 0, 0, 0);
#pragma unroll
            for (int d0 = 1; d0 < 4; ++d0) {
                p0 = __builtin_amdgcn_mfma_f32_32x32x16_bf16(kf[2 * d0], qr[d0], p0, 0, 0, 0);
                p1 = __builtin_amdgcn_mfma_f32_32x32x16_bf16(kf[2 * d0 + 1], qr[d0], p1, 0, 0, 0); }
            const bf16_t* ksrc = (st < 3) ? kfp + (size_t)(2 * (st + 1)) * 4 * 512 : kfn;
#pragma unroll
            for (int d0 = 0; d0 < 4; ++d0) { kf[2 * d0] = *(const bf16x8*)(ksrc + (0 * 4 + d0) * 512); kf[2 * d0 + 1] = *(const bf16x8*)(ksrc + (1 * 4 + d0) * 512); }
            if (st == 3) { const bf16_t* Qw = T.Q + (rowbase + qposn) * (long)T.qp;
#pragma unroll
                for (int d0 = 0; d0 < 4; ++d0) qn[d0] = *(const bf16x8*)(Qw + d0 * 16 + hi * 8); }
            if (!allu) {
                const LAS float* bp = biasL + (qpos - kb4 - 59);
#pragma unroll
                for (int r = 0; r < 16; ++r) { const int cr = (r & 3) + 8 * (r >> 2); p0[r] += bp[59 - cr]; p1[r] += bp[59 - cr - 32]; }
            }
        };
        auto pack = [&]() {
#pragma unroll
            for (int i = 0; i < 4; ++i) { pw[0][i] = cvtpk_s(p0[2 * i], p0[2 * i + 1]); pw[1][i] = cvtpk_s(p0[8 + 2 * i], p0[8 + 2 * i + 1]); pw[2][i] = cvtpk_s(p1[2 * i], p1[2 * i + 1]); pw[3][i] = cvtpk_s(p1[8 + 2 * i], p1[8 + 2 * i + 1]); }
        };
        qk_bias(0);
        { float sacc;
#pragma unroll
          for (int r = 0; r < 16; ++r) { p0[r] = __builtin_amdgcn_exp2f(p0[r]); p1[r] = __builtin_amdgcn_exp2f(p1[r]); }
          f32x2 s2 = {0.f, 0.f};
#pragma unroll
          for (int i = 0; i < 8; ++i) { s2 += (f32x2){p0[2 * i], p0[2 * i + 1]}; s2 += (f32x2){p1[2 * i], p1[2 * i + 1]}; }
          sacc = s2.x + s2.y; lsum += sacc; }
        pack();
#pragma unroll 1
        for (int st = 1; st < 4; ++st) {
            if (st == 2) { tn = fetch(); hn = tn < ntiles;
                const unsigned ten = tiles[hn ? tn : ti]; offn = (int)(ten & 0xffffu); jn = (int)(ten >> 16);
                v16n = list[offn + r32]; validn = v16n != 0xFFFFu; qposn = q0 + (validn ? (int)(v16n & 255u) : 0);
                kfn = T.KF + (((size_t)bh * 256 + (size_t)jn * 8) * 4 * 64 + lane) * 8; }
            qk_bias(st);
            f32x2 s2 = {0.f, 0.f};
#pragma unroll
            for (int g = 0; g < 8; ++g) {
                o[g >> 2] = __builtin_amdgcn_mfma_f32_32x32x16_bf16(__builtin_bit_cast(bf16x8, pw[g & 3]), vf[g], o[g >> 2], 0, 0, 0);
                p0[2 * g] = __builtin_amdgcn_exp2f(p0[2 * g]); p0[2 * g + 1] = __builtin_amdgcn_exp2f(p0[2 * g + 1]); p1[2 * g] = __builtin_amdgcn_exp2f(p1[2 * g]); p1[2 * g + 1] = __builtin_amdgcn_exp2f(p1[2 * g + 1]);
                s2 += (f32x2){p0[2 * g], p0[2 * g + 1]}; s2 += (f32x2){p1[2 * g], p1[2 * g + 1]};
            }
            lsum += s2.x + s2.y;
#pragma unroll
            for (int k = 0; k < 4; ++k) { vf[k] = *(const bf16x8*)(vfp + ((size_t)(4 * st + k) * 2 + 0) * 512); vf[4 + k] = *(const bf16x8*)(vfp + ((size_t)(4 * st + k) * 2 + 1) * 512); }
            pack();
        }
#pragma unroll
        for (int g = 0; g < 8; ++g) o[g >> 2] = __builtin_amdgcn_mfma_f32_32x32x16_bf16(__builtin_bit_cast(bf16x8, pw[g & 3]), vf[g], o[g >> 2], 0, 0, 0);
        const bf16_t* vfn = T.VF + (((size_t)bh * 512 + (size_t)jn * 16) * 2 * 64 + lane) * 8;
#pragma unroll
        for (int k = 0; k < 4; ++k) { vf[k] = *(const bf16x8*)(vfn + ((size_t)k * 2 + 0) * 512); vf[4 + k] = *(const bf16x8*)(vfn + ((size_t)k * 2 + 1) * 512); }
        { auto rr = __builtin_amdgcn_permlane32_swap(__float_as_uint(lsum), __float_as_uint(lsum), false, false); lsum = __uint_as_float(rr[0]) + __uint_as_float(rr[1]); }
        if (hi == 0 && valid) lpl[((v16 >> 8) & 3u) * 256 + (int)(v16 & 255u)] = lsum;
        unsigned er[16];
#pragma unroll
        for (int r = 0; r < 16; ++r) er[r] = list[off + crow(r, hi)];
#pragma unroll
        for (int r = 0; r < 16; ++r) if (er[r] != 0xFFFFu) { LAS bf16_t* dst = pl + ((er[r] >> 8) & 3u) * 16384 + (er[r] & 255u) * 64 + r32;
            const unsigned w2 = pk2(o[0][r], o[1][r]); dst[0] = (bf16_t)(w2 & 0xffffu); dst[32] = (bf16_t)(w2 >> 16); }
        if (!hn) break;
        ti = tn; off = offn; j = jn; v16 = v16n; valid = validn; qpos = qposn; kfp = kfn; vfp = vfn;
#pragma unroll
        for (int d0 = 0; d0 < 4; ++d0) qr[d0] = qn[d0];
    }
}

__device__ __forceinline__ void unit(const Tens& T, int b, int h, int qb, LAS char* lds, unsigned* qnext, volatile LAS unsigned* qslot) {
    const int tid = launder(tidx()), lane = tid & 63, r32 = lane & 31, hi = lane >> 5; const int wid = __builtin_amdgcn_readfirstlane(tid >> 6);
    const long rowbase = (long)b * SEQ; const int q0 = qb * 256, bh = b * 8 + h;
    LAS bf16_t* pl = (LAS bf16_t*)(lds + L_PL); LAS float* lpl = (LAS float*)(lds + L_LPL);
    const LAS float* biasL = (const LAS float*)(lds + L_BIAS);
    LAS unsigned short* list = (LAS unsigned short*)(lds + L_LIST);
    LAS unsigned* tiles = (LAS unsigned*)(lds + L_TILES); LAS unsigned* cntw = (LAS unsigned*)(lds + L_CNT); LAS unsigned* startv = (LAS unsigned*)(lds + L_START);
    LAS unsigned* misc = (LAS unsigned*)(lds + L_MISC);
    const int npick = qb < 3 ? qb : 3;
    f32x4 bt[4];
#pragma unroll
    for (int i = 0; i < 4; ++i) bt[i] = *(const f32x4*)(T.bias + (tid + 512 * i) * 4);
    for (int i = tid; i < LIST_N / 2; i += 512) ((LAS unsigned*)(lds + L_LIST))[i] = 0xFFFFFFFFu;
    if (tid == 0) misc[0] = 0u;
    unsigned selm = 0u;
    if (qb > 0) {
        LAS float* kmL = (LAS float*)(lds + L_PL);
        LAS float* part = (LAS float*)(lds + L_PL + 8192);
        const int r = tid & 255, half = tid >> 8;
        u32x4 qw_[4];
        { const bf16_t* qp_ = T.Q + (rowbase + q0 + r) * (long)T.qp + 32 * half;
#pragma unroll
          for (int c = 0; c < 4; ++c) qw_[c] = *(const u32x4*)(qp_ + 8 * c); }
        float ks_[4][4];
#pragma unroll
        for (int k = 0; k < 4; ++k) { const int idx = tid + 512 * k, idc = idx < qb * 64 ? idx : 0, j = idc >> 6, d = idc & 63;
            const float* p = T.kpart + ((size_t)(b * 32 + j) * 4) * 512 + h * 64 + d;
#pragma unroll
            for (int c = 0; c < 4; ++c) ks_[k][c] = p[512 * c]; }
        SBAR();
#pragma unroll
        for (int k = 0; k < 4; ++k) { const int idx = tid + 512 * k; if (idx < qb * 64) kmL[idx] = (((ks_[k][0] + ks_[k][1]) + ks_[k][2]) + ks_[k][3]) * (1.0f / 256.0f); }
        float q[32];
#pragma unroll
        for (int c = 0; c < 4; ++c)
#pragma unroll
            for (int e = 0; e < 4; ++e) { q[8 * c + 2 * e] = bflo(qw_[c][e]); q[8 * c + 2 * e + 1] = bfhi(qw_[c][e]); }
        __syncthreads();
        for (int j = 0; j < qb; ++j) { const LAS float* kmp = kmL + j * 64 + 32 * half; float d0 = 0.f, d1 = 0.f, d2 = 0.f, d3 = 0.f;
#pragma unroll
            for (int c = 0; c < 8; ++c) { const f32x4 kv = *(const LAS f32x4*)(kmp + 4 * c); d0 += q[4 * c] * kv.x; d1 += q[4 * c + 1] * kv.y; d2 += q[4 * c + 2] * kv.z; d3 += q[4 * c + 3] * kv.w; }
            part[(half * 32 + j) * 256 + r] = (d0 + d1) + (d2 + d3); }
        __syncthreads();
        if (tid < 256) {
            float v0 = -INFINITY, v1 = -INFINITY, v2 = -INFINITY; int i0 = 0, i1 = 0, i2 = 0;
            for (int j = 0; j < qb; ++j) { const float d = part[j * 256 + tid] + part[(32 + j) * 256 + tid];
                if (d > v0) { v2 = v1; i2 = i1; v1 = v0; i1 = i0; v0 = d; i0 = j; } else if (d > v1) { v2 = v1; i2 = i1; v1 = d; i1 = j; } else if (d > v2) { v2 = d; i2 = j; } }
            selm = 1u << i0; if (qb > 1) selm |= 1u << i1; if (qb > 2) selm |= 1u << i2;
        }
    }
    int pj0 = 0, pj1 = 0, pj2 = 0; unsigned pr0 = 0u, pr1 = 0u, pr2 = 0u;
    if (wid < 4) {
        unsigned mycnt = 0u;
        for (int j = 0; j < qb; ++j) { const unsigned bit = (selm >> j) & 1u; const unsigned long long m = __ballot(bit);
            const unsigned c = (unsigned)__popcll(m), rank = (unsigned)__popcll(m & ((1ull << lane) - 1ull)), kk = (unsigned)__popc(selm & ((1u << j) - 1u));
            mycnt = (lane == j) ? c : mycnt;
            if (bit && kk == 0u) { pj0 = j; pr0 = rank; }
            if (bit && kk == 1u) { pj1 = j; pr1 = rank; }
            if (bit && kk == 2u) { pj2 = j; pr2 = rank; } }
        if (lane < 32) cntw[wid * 32 + lane] = mycnt;
    }
    __syncthreads();
    if (wid == 0) {
        const int j = lane & 31; unsigned n = 0u;
        if (j < qb) n = cntw[j] + cntw[32 + j] + cntw[64 + j] + cntw[96 + j];
        const unsigned tl = (n + 31u) >> 5; unsigned excl = 0u, total = 0u;
#pragma unroll
        for (int k = 0; k < 32; ++k) { const unsigned v = (unsigned)__builtin_amdgcn_readlane((int)tl, k); excl += (k < j) ? v : 0u; total += v; }
        if (lane < 32) { startv[j] = 32u * excl; for (unsigned c = 0; c < tl; ++c) tiles[excl + c] = ((unsigned)j << 16) | (32u * (excl + c)); }
        if (lane == 0) misc[1] = total;
    }
    { LAS f32x4* bl = (LAS f32x4*)(lds + L_BIAS);
#pragma unroll
      for (int i = 0; i < 4; ++i) bl[tid + 512 * i] = bt[i]; }
    __syncthreads();
    if (wid < 4) {
        if (npick > 0) { unsigned base = startv[pj0]; for (int w = 0; w < wid; ++w) base += cntw[w * 32 + pj0]; list[base + pr0] = (unsigned short)((unsigned)tid); }
        if (npick > 1) { unsigned base = startv[pj1]; for (int w = 0; w < wid; ++w) base += cntw[w * 32 + pj1]; list[base + pr1] = (unsigned short)((unsigned)tid | (1u << 8)); }
        if (npick > 2) { unsigned base = startv[pj2]; for (int w = 0; w < wid; ++w) base += cntw[w * 32 + pj2]; list[base + pr2] = (unsigned short)((unsigned)tid | (2u << 8)); }
    }
    __syncthreads();
    const unsigned ntiles = misc[1];
    pair_stream(T, biasL, bh, q0, rowbase, lane, r32, hi, ntiles, misc, tiles, list, pl, lpl);
    const int oi = (wid < 4) ? wid : 11 - wid;
    u32x4 gpf[4];
    { const int le = launder(tidx()) & 63; const long or0 = rowbase + q0 + oi * 32;
#pragma unroll
      for (int i = 0; i < 4; ++i) gpf[i] = *(const u32x4*)(T.G + (or0 + i * 8 + (le >> 3)) * (long)T.gp + (le & 7) * 8); }
    SBAR();
    if (launder(tidx()) == 0) *qslot = __hip_atomic_fetch_add(qnext, 1u, __ATOMIC_RELAXED, __HIP_MEMORY_SCOPE_AGENT);
    f32x16 oo[2]; float lown;
    tile<true>(T, biasL, bh, qb, (oi >> 1) + 1, q0 + 32 * oi + r32, true, rowbase, lane, hi, oo, lown);
    __syncthreads();
    {
        f32x16 (&o)[2] = oo; float lsum = lown;
        { auto rr = __builtin_amdgcn_permlane32_swap(__float_as_uint(lsum), __float_as_uint(lsum), false, false); lsum = __uint_as_float(rr[0]) + __uint_as_float(rr[1]); }
        for (int k = 0; k < npick; ++k) lsum += lpl[k * 256 + 32 * oi + r32];
        for (int k = 0; k < npick; ++k) {
#pragma unroll
            for (int r = 0; r < 16; ++r) { const LAS bf16_t* src = pl + k * 16384 + (32 * oi + crow(r, hi)) * 64 + r32;
                o[0][r] += __builtin_bit_cast(float, (unsigned)src[0] << 16); o[1][r] += __builtin_bit_cast(float, (unsigned)src[32] << 16); }
        }
        LAS float* ltot = lpl + 3 * 256 - 256 + 0;
        (void)ltot;
        LAS float* lrow = (LAS float*)(lds + L_LIST) + 32 * oi;
        if (hi == 0) lrow[r32] = lsum;
        float rli[16];
#pragma unroll
        for (int r = 0; r < 16; ++r) rli[r] = 1.0f / lrow[crow(r, hi)];
        LAS bf16_t* stg = pl + (32 * oi) * 64;
#pragma unroll
        for (int r = 0; r < 16; ++r) { const int orow = crow(r, hi);
#pragma unroll
            for (int d0 = 0; d0 < 2; ++d0) stg[orow * 64 + d0 * 32 + r32] = (bf16_t)f2bf(o[d0][r] * rli[r]); }
        LDS_WAIT();
        const long orow0 = rowbase + q0 + oi * 32; const int lane_e = launder(tidx()) & 63;
#pragma unroll
        for (int i = 0; i < 4; ++i) { const int row = i * 8 + (lane_e >> 3), ch = lane_e & 7;
            const u32x4 ov = *(const LAS u32x4*)(stg + row * 64 + ch * 8);
            const u32x4 gv = gpf[i];
            u32x4 res;
#pragma unroll
            for (int e = 0; e < 4; ++e) { const float g0 = bflo(gv[e]), g1_ = bfhi(gv[e]);
                const float s0 = g0 / (1.0f + __expf(-g0)), s1 = g1_ / (1.0f + __expf(-g1_));
                res[e] = pk2(bflo(ov[e]) * s0, bfhi(ov[e]) * s1); }
            store16_wt(T.O + (orow0 + row) * (long)T.op + ch * 8, res); }
    }
    __syncthreads();
}
}

#define XB_TMO      128
#define XB_XCNT(j)  (256  + 64 * (j))
#define XB_XSUB(j)  (1280 + 64 * (j))
#define XB_XGEN(j)  (2304 + 64 * (j))
#define XB_TOP      3328
#define XB_TOPGEN   3392
#define XCD_BAR_WORDS 3456
#define XB_SPIN_CAP (1u << 18)
__device__ __forceinline__ unsigned xb_ld(unsigned* p)              { return __hip_atomic_load(p, __ATOMIC_RELAXED, __HIP_MEMORY_SCOPE_AGENT); }
__device__ __forceinline__ unsigned xb_add(unsigned* p, unsigned v) { return __hip_atomic_fetch_add(p, v, __ATOMIC_RELAXED, __HIP_MEMORY_SCOPE_AGENT); }
__device__ __forceinline__ unsigned xb_xcc_id() { return (unsigned)__builtin_amdgcn_s_getreg((3 << 11) | 20) & 0xFu; }
#define XB_SPIN(cond, bar) do { unsigned _sp = 0; while (cond) { __builtin_amdgcn_s_sleep(1); \
    if ((++_sp & 255u) == 0u) { if (xb_ld(&(bar)[XB_TMO])) break; if (_sp > XB_SPIN_CAP) { atomicAdd(&(bar)[XB_TMO], 1u); break; } } } } while (0)
struct XcdBarrier { unsigned* bar; unsigned x; volatile LAS unsigned* st; };
__device__ __forceinline__ XcdBarrier xcd_barrier_post(unsigned* bar, volatile LAS unsigned* st) {
    XcdBarrier b; b.bar = bar; b.x = xb_xcc_id(); b.st = st;
    if (threadIdx.x == 0) (void)xb_add(&bar[XB_XCNT(b.x)], 1u);
    return b;
}
__device__ __forceinline__ void xcd_barrier_complete(unsigned* bar, unsigned x, unsigned& nloc, unsigned& nx) {
    const unsigned G = gridDim.x * gridDim.y * gridDim.z;
    unsigned sum, cnt, mine, sp = 0u;
    for (;;) {
        sum = 0u; cnt = 0u; mine = 0u;
#pragma unroll
        for (unsigned j = 0; j < 16; ++j) { const unsigned c = xb_ld(&bar[XB_XCNT(j)]); sum += c; cnt += (c > 0u) ? 1u : 0u; }
        mine = xb_ld(&bar[XB_XCNT(x)]);
        if (sum == G) break;
        __builtin_amdgcn_s_sleep(1);
        if ((++sp & 255u) == 0u) { if (xb_ld(&bar[XB_TMO])) break; if (sp > XB_SPIN_CAP) { atomicAdd(&bar[XB_TMO], 1u); break; } }
    }
    nloc = mine > 0u ? mine : 1u; nx = cnt > 0u ? cnt : 1u;
}
__device__ __forceinline__ void xcd_barrier(const XcdBarrier& b) {
    asm volatile("s_waitcnt vmcnt(0)" ::: "memory");
    __syncthreads();
    if (tidx() == 0) {
        unsigned* bar = b.bar; asm volatile("" : "+s"(bar));
        __builtin_amdgcn_s_waitcnt(0);
        unsigned nloc = b.st[0], nx = b.st[1];
        if (nloc == 0u) { xcd_barrier_complete(bar, b.x, nloc, nx); b.st[0] = nloc; b.st[1] = nx; }
        const unsigned old = xb_add(&bar[XB_XSUB(b.x)], 1u);
        const unsigned gen = old / nloc;
        __builtin_amdgcn_fence(__ATOMIC_ACQUIRE, "agent");
        if (old + 1u == (gen + 1u) * nloc) {
            __builtin_amdgcn_fence(__ATOMIC_RELEASE, "agent");
            asm volatile("s_waitcnt vmcnt(0)" ::: "memory");
            const unsigned og = xb_add(&bar[XB_TOP], 1u);
            const unsigned tg = og / nx;
            if (og + 1u == (tg + 1u) * nx) xb_add(&bar[XB_TOPGEN], 1u);
            else XB_SPIN(xb_ld(&bar[XB_TOPGEN]) == tg, bar);
            xb_add(&bar[XB_XGEN(b.x)], 1u);
            asm volatile("s_waitcnt vmcnt(0)" ::: "memory");
        } else {
            XB_SPIN(xb_ld(&bar[XB_XGEN(b.x)]) == gen, bar);
            asm volatile("s_waitcnt vmcnt(0)" ::: "memory");
        }
    }
    __syncthreads();
}

constexpr int NWAVES = 8;
constexpr int RING_BYTES = 143360, LDSCTL_OFF = RING_BYTES, MISC_OFF = LDSCTL_OFF + 320, LDS_BYTES = 147456;
static_assert(att::L_END <= RING_BYTES && moba::L_END <= RING_BYTES && pg8::STAGE_BYTES <= RING_BYTES && WTAB_LDS == (unsigned)MISC_OFF + 128 && WTAB_LDS + 256 <= (unsigned)LDS_BYTES, "LDS map");

struct Args {
    const float* x; const float* c; const int* pos; const float* norm_g; const float* w_ada; const float* b_ada; const float* w_in;
    const float* q_norm_g; const float* w_uq; const float* kv_norm_g; const float* w_ukv; const float* q_g; const float* k_g;
    const float* mq_g; const float* mk_g; const float* w_out; const float* rel_bias;
    float* out; unsigned char* ws; int ph_lo, ph_hi;
};

__device__ __forceinline__ void transpose_item(const float* W, int K, int N, bf16_t* WT, int dstrow0, int k0, int n0, LAS float* scr, int lane) {
#pragma unroll 8
    for (int i = 0; i < 32; ++i) { const int kk = 2 * i + (lane >> 5); scr[kk * 33 + (lane & 31)] = W[(size_t)(k0 + kk) * N + n0 + (lane & 31)]; }
    LDS_WAIT(); asm volatile("" ::: "memory");
    const int c = lane & 7;
#pragma unroll
    for (int j = 0; j < 4; ++j) { const int n = (lane >> 3) + 8 * j; const LAS float* s = scr + (8 * c) * 33 + n;
        u32x4 o; o.x = pk2(s[0 * 33], s[1 * 33]); o.y = pk2(s[2 * 33], s[3 * 33]); o.z = pk2(s[4 * 33], s[5 * 33]); o.w = pk2(s[6 * 33], s[7 * 33]);
        *(u32x4*)(WT + (size_t)(dstrow0 + n) * K + k0 + 8 * c) = o; }
    LDS_WAIT(); asm volatile("" ::: "memory");
}

__global__ void __launch_bounds__(NWAVES * 64, 2) mk_fwd(Args A) {
    extern __shared__ __attribute__((aligned(16))) unsigned char lds_raw[];
    LAS unsigned char* lds = (LAS unsigned char*)lds_raw;
    volatile LAS unsigned* MISC = (volatile LAS unsigned*)(lds + MISC_OFF);
    const int tid = threadIdx.x, lane = tid & 63, wave = __builtin_amdgcn_readfirstlane(tid >> 6);
    const int G = gridDim.x, bx = blockIdx.x;
    const int vcu = (G % 8 == 0) ? (bx % 8) * (G / 8) + bx / 8 : bx;
    typedef __attribute__((address_space(4))) const Args* KArgsP;
    KArgsP kp0 = (KArgsP)__builtin_amdgcn_kernarg_segment_ptr();
    unsigned* ctl = (unsigned*)(A.ws + WS_CTL);
#define PH_ARGS KArgsP Ap = kp0; asm volatile("" : "+s"(Ap)); unsigned char* ws = Ap->ws; (void)ws; const int bx = launder_s32((int)blockIdx.x); (void)bx; \
    float* modb = (float*)(ws + WS_MOD); float* biasT = (float*)(ws + WS_BIAS); float* kpart = (float*)(ws + WS_KPART); float* ropeT = (float*)(ws + WS_ROPE); \
    bf16_t* Hb = (bf16_t*)(ws + WS_H); bf16_t* Zb = (bf16_t*)(ws + WS_Z); bf16_t* Qb = (bf16_t*)(ws + WS_Q); bf16_t* KVb = (bf16_t*)(ws + WS_KV); bf16_t* Kb = (bf16_t*)(ws + WS_K); \
    (void)modb; (void)biasT; (void)kpart; (void)ropeT; (void)Hb; (void)Zb; (void)Qb; (void)KVb; (void)Kb;
    for (int u = tid; u < (LDS_BYTES - LDSCTL_OFF) / 4; u += NWAVES * 64) ((LAS unsigned*)(lds + LDSCTL_OFF))[u] = 0u;
    __syncthreads();
    if ((threadIdx.x & 63) == 0) ((volatile LAS unsigned*)(size_t)WTAB_LDS)[hw_slot()] = threadIdx.x >> 6;
    __syncthreads();
    XcdBarrier bar; bar.bar = ctl + CW_BAR; bar.x = 0; bar.st = nullptr;
    if (MK_ONE_LAUNCH) bar = xcd_barrier_post(ctl + CW_BAR, MISC + 8);
    const int lo = A.ph_lo, hi_ = A.ph_hi;
#define IN(k) (lo <= (k) && (k) < hi_)
#define SEAM(k) do { if (IN(k) && IN((k) + 1)) xcd_barrier(bar); } while (0)

    if (IN(0)) { PH_ARGS const int tid = launder(tidx()), lane = tid & 63, wave = __builtin_amdgcn_readfirstlane(tid >> 6); (void)tid; (void)lane; (void)wave;
        if (bx < 96) {
            const int l = bx / 48, n0 = (bx % 48) * 64;
            LAS float* sc = (LAS float*)lds;
            for (int i = tid; i < 2 * DMODEL; i += 512) { const float v = Ap->c[i]; sc[i] = v / (1.0f + __expf(-v)); }
            __syncthreads();
            float a0 = 0.f, a1 = 0.f; const float* wp = Ap->w_ada + ((size_t)l * DMODEL + wave * 128) * 3072 + n0 + lane;
#pragma unroll 1
            for (int k0 = 0; k0 < 128; k0 += 32) { float wv[32];
#pragma unroll
                for (int k = 0; k < 32; ++k) wv[k] = wp[(size_t)(k0 + k) * 3072];
#pragma unroll
                for (int k = 0; k < 32; ++k) { a0 += sc[wave * 128 + k0 + k] * wv[k]; a1 += sc[DMODEL + wave * 128 + k0 + k] * wv[k]; } }
            LAS float* red = (LAS float*)(lds + 8192);
            red[(wave * 2 + 0) * 64 + lane] = a0; red[(wave * 2 + 1) * 64 + lane] = a1;
            __syncthreads();
            if (wave == 0) { float s0 = 0.f, s1 = 0.f;
#pragma unroll
                for (int w = 0; w < 8; ++w) { s0 += red[(w * 2 + 0) * 64 + lane]; s1 += red[(w * 2 + 1) * 64 + lane]; }
                const float bb = Ap->b_ada[l * 3072 + n0 + lane];
                modb[(l * 2 + 0) * 3072 + n0 + lane] = s0 + bb; modb[(l * 2 + 1) * 3072 + n0 + lane] = s1 + bb; }
            __syncthreads();
        }
        {
            LAS float* scr = (LAS float*)(lds + wave * 16384);
            const int gw = bx * NWAVES + wave, NGW = G * NWAVES;
            constexpr int I_IN = 16 * 93, I_OUT = 16 * 32, I_L = I_IN + I_OUT;
            constexpr int NFAST = (256 - 96) * NWAVES, NBULK = 3 * NFAST;
            static_assert(DEPTH * I_L - NBULK <= 96 * NWAVES && DEPTH * I_L >= NBULK, "P0 item split");
            const bool fastwg = (G == 256) && bx >= 96;
            const int it0 = (G != 256) ? gw : (fastwg ? gw - 96 * NWAVES : NBULK + gw), itstep = (G != 256) ? NGW : (fastwg ? NFAST : DEPTH * I_L), itend = (G != 256 || !fastwg) ? DEPTH * I_L : NBULK;
            for (int it = it0; it < itend; it += itstep) {
                const int l = it / I_L; int r = it % I_L; unsigned char* wl = ws + WS_W + (size_t)l * W_LAYER;
                if (r < I_IN) { const int kb = r / 93, nb = r % 93; transpose_item(Ap->w_in + (size_t)l * DMODEL * D_IN, DMODEL, D_IN, (bf16_t*)(wl + W_IN), (nb >= 13 ? 96 : 0) + nb * 32, kb * 64, nb * 32, scr, lane); continue; } r -= I_IN;
                { const int kb = r / 32, nb = r % 32; transpose_item(Ap->w_out + (size_t)l * DMODEL * DMODEL, DMODEL, DMODEL, (bf16_t*)(wl + W_OUT), nb * 32, kb * 64, nb * 32, scr, lane); }
            }
        }
        {
            const int gt = bx * 512 + tid, NT_ = G * 512;
            for (int i = gt; i < DEPTH * 96 * 128; i += NT_) { const int l = i / (96 * 128), r = i % (96 * 128);
                *(u32x4*)(ws + WS_W + (size_t)l * W_LAYER + W_IN + (size_t)416 * 2048 + (size_t)r * 16) = (u32x4){0u, 0u, 0u, 0u}; }
            for (int i = gt; i < DEPTH * 40960; i += NT_) { const int l = i / 40960, r = i % 40960; unsigned char* wl = ws + WS_W + (size_t)l * W_LAYER;
                const float* W; int N, n, k0; unsigned char* dst;
                if (r < 24576) { const int ln = r & 63; int q = r >> 6; const int nb = q % 3; q /= 3; const int ks = q & 15, h = q >> 4;
                    n = 96 * h + 32 * nb + (ln & 31); k0 = 16 * ks + 8 * (ln >> 5); W = Ap->w_uq + (size_t)l * QLORA * NQ; N = NQ; dst = wl + W_UQ + (size_t)r * 16; }
                else { const int r2 = r - 24576, ln = r2 & 63, q = r2 >> 6, nb = q & 1, ks = (q >> 1) & 7, h = (q >> 4) & 7, isv = q >> 7;
                    n = 128 * h + 64 * isv + 32 * nb + (ln & 31); k0 = 16 * ks + 8 * (ln >> 5); W = Ap->w_ukv + (size_t)l * KVLORA * NKV; N = NKV; dst = wl + W_UKV + (size_t)r2 * 16; }
                float f[8];
#pragma unroll
                for (int j = 0; j < 8; ++j) f[j] = W[(size_t)(k0 + j) * N + n];
                u32x4 o; o.x = pk2(f[0], f[1]); o.y = pk2(f[2], f[3]); o.z = pk2(f[4], f[5]); o.w = pk2(f[6], f[7]);
                *(u32x4*)dst = o; }
            for (int i = gt; i < M * 16; i += NT_) { const int row = i >> 4, j = i & 15;
                const float invf = powf(10000.0f, -(float)j / 16.0f); const float ang = (float)Ap->pos[row] * invf;
                float sn, cs; sincosf(ang, &sn, &cs); ropeT[row * 32 + j] = cs; ropeT[row * 32 + 16 + j] = sn; }
            for (int i = gt; i < 8 * 8192; i += NT_) { const int h = i >> 13, d = i & 8191;
                int bk; if (d < 16) bk = d; else { bk = 8 + (31 - __clz(d * d)); if (bk > 31) bk = 31; }
                biasT[i] = Ap->rel_bias[bk * 8 + h] * LOG2E; }
        }
    }
    SEAM(0);

#pragma unroll 1
    for (int l = 0; l < DEPTH; ++l) {
        const int P = 1 + 5 * l;
#define WL (ws + WS_W + (size_t)l * W_LAYER)
#define XIN ((l == 0) ? Ap->x : Ap->out)
        if (IN(P)) { PH_ARGS const int tid = launder(tidx()), lane = tid & 63, wave = __builtin_amdgcn_readfirstlane(tid >> 6); (void)tid; (void)lane; (void)wave;
            const int gw = bx * NWAVES + wave; const int b = (gw * 8) / SEQ;
            const float* mv = modb + (l * 2 + b) * 3072;
            f32x4 ga[4], sh[4];
#pragma unroll
            for (int j = 0; j < 4; ++j) { const int c0 = 4 * lane + 256 * j; const f32x4 g4 = *(const f32x4*)(Ap->norm_g + l * DMODEL + c0); const f32x4 s4 = *(const f32x4*)(mv + DMODEL + c0); ga[j] = g4 * (s4 + 1.0f); sh[j] = *(const f32x4*)(mv + c0); }
            for (int i0 = 0; i0 < 8; i0 += 4) {
                f32x4 v[4][4]; float ss[4];
#pragma unroll
                for (int u = 0; u < 4; ++u) { const size_t row = (size_t)gw * 8 + i0 + u; ss[u] = 0.f;
#pragma unroll
                    for (int j = 0; j < 4; ++j) { v[u][j] = *(const f32x4*)(XIN + row * DMODEL + 4 * lane + 256 * j); ss[u] += (v[u][j].x * v[u][j].x + v[u][j].y * v[u][j].y) + (v[u][j].z * v[u][j].z + v[u][j].w * v[u][j].w); } }
#pragma unroll
                for (int u = 0; u < 4; ++u) ss[u] = 1.0f / sqrtf(wave_sum(ss[u]) * (1.0f / DMODEL) + EPS);
#pragma unroll
                for (int u = 0; u < 4; ++u) { const size_t row = (size_t)gw * 8 + i0 + u;
#pragma unroll
                    for (int j = 0; j < 4; ++j) { const f32x4 hv = v[u][j] * ss[u] * ga[j] + sh[j]; u32x2 w; w.x = pk2(hv.x, hv.y); w.y = pk2(hv.z, hv.w); *(u32x2*)(Hb + row * DMODEL + 4 * lane + 256 * j) = w; } }
            }
        }
        SEAM(P);
        if (IN(P + 1)) { PH_ARGS
            pg8::Gemm g{Hb, (const bf16_t*)(WL + W_IN), M, ZP, DMODEL, DMODEL, DMODEL}; pg8::StaticOrder S; S.init(M, ZP, G, launder_s32(bx));
            pg8::EpiBf16 E{Zb, ZP};
            pg8::gemm_phase<pg8::EpiBf16>(lds, g, S, E);
        }
        SEAM(P + 1);
        if (IN(P + 2)) { PH_ARGS const int tid = launder(tidx()), lane = tid & 63, wave = __builtin_amdgcn_readfirstlane(tid >> 6); (void)tid; (void)lane; (void)wave;
            const int sub = lane & 7, r32 = lane & 31, hi = lane >> 5;
            constexpr int SROW = 1040;
            LAS unsigned char* stg = lds; LAS float* red = (LAS float*)(lds + 64 * SROW);
            constexpr int XQ_OFF = 64 * SROW + 16384, XQ_P = 528, XKV_OFF = XQ_OFF + 64 * XQ_P, XKV_P = 272, GQ_OFF = XKV_OFF + 64 * XKV_P, GK_OFF = GQ_OFF + 384, OST_W = 6656;
            static_assert(GK_OFF + 384 <= RING_BYTES && 8 * OST_W <= 64 * SROW, "phase C LDS map");
            if (tid < 96) { *(LAS float*)(lds + GQ_OFF + tid * 4) = Ap->q_g[l * 96 + tid]; *(LAS float*)(lds + GK_OFF + tid * 4) = Ap->k_g[l * 96 + tid]; }
            const int b = bx / 128, s0 = (bx % 128) * 64;
            bf16_t* KFb = (bf16_t*)(ws + WS_KF); bf16_t* VFb = (bf16_t*)(ws + WS_VF);
            u32x4 vrow[8];
#pragma unroll
            for (int i = 0; i < 8; ++i) vrow[i] = *(const u32x4*)(Zb + ((size_t)bx * 64 + wave * 8 + i) * ZP + ZC_VB + 8 * lane);
            const f32x4 rope_pf = *(const f32x4*)(ropeT + ((size_t)bx * 64 + (tid >> 3)) * 32 + (tid & 7) * 4);
            const u32x4 kr_pf = *(const u32x4*)(Zb + ((size_t)bx * 64 + ((tid & 255) >> 2)) * ZP + ZC_KROPE + (tid & 3) * 8);
            constexpr int ROPE_L = 64 * SROW, ROPE_P = 144, KR_L = ROPE_L + 64 * ROPE_P, KR_P = 80;
            static_assert(KR_L + 64 * KR_P <= 64 * SROW + 16384, "rope / k_rope LDS tables");
            float kacc[8];
#pragma unroll
            for (int e = 0; e < 8; ++e) kacc[e] = 0.f;
            f32x4 qng = *(const f32x4*)(Ap->q_norm_g + l * QLORA + 4 * lane); f32x2 kng = *(const f32x2*)(Ap->kv_norm_g + l * KVLORA + 2 * lane);
            float mqg[8], mkg[8];
#pragma unroll
            for (int e = 0; e < 8; ++e) { mqg[e] = Ap->mq_g[l * 64 + 8 * sub + e] * QSCALE_B; mkg[e] = Ap->mk_g[l * 64 + 8 * sub + e]; }
            for (int i0 = 0; i0 < 8; i0 += 4) {
                u32x2 cw[4]; unsigned dw[4]; u32x4 qw[4], kw[4]; float rq[4], rk[4];
#pragma unroll
                for (int u = 0; u < 4; ++u) { const bf16_t* zr = Zb + ((size_t)bx * 64 + wave * 8 + i0 + u) * ZP;
                    cw[u] = *(const u32x2*)(zr + ZC_CQ + 4 * lane); dw[u] = *(const unsigned*)(zr + ZC_CKV + 2 * lane); qw[u] = *(const u32x4*)(zr + ZC_QB + 8 * lane); kw[u] = *(const u32x4*)(zr + ZC_KB + 8 * lane); }
#pragma unroll
                for (int u = 0; u < 4; ++u) { const float a0 = bflo(cw[u].x), a1 = bfhi(cw[u].x), a2 = bflo(cw[u].y), a3 = bfhi(cw[u].y), c0 = bflo(dw[u]), c1 = bfhi(dw[u]);
                    rq[u] = (a0 * a0 + a1 * a1) + (a2 * a2 + a3 * a3); rk[u] = c0 * c0 + c1 * c1; }
#pragma unroll
                for (int u = 0; u < 4; ++u) { rq[u] = 1.0f / sqrtf(wave_sum(rq[u]) * (1.0f / QLORA) + EPS); rk[u] = 1.0f / sqrtf(wave_sum(rk[u]) * (1.0f / KVLORA) + EPS); }
#pragma unroll
                for (int u = 0; u < 4; ++u) { bf16_t* zr = Zb + ((size_t)bx * 64 + wave * 8 + i0 + u) * ZP;
                    { const float v0 = bflo(cw[u].x), v1 = bfhi(cw[u].x), v2 = bflo(cw[u].y), v3 = bfhi(cw[u].y);
                      u32x2 o; o.x = pk2(v0 * rq[u] * qng.x, v1 * rq[u] * qng.y); o.y = pk2(v2 * rq[u] * qng.z, v3 * rq[u] * qng.w); *(LAS u32x2*)(lds + XQ_OFF + (wave * 8 + i0 + u) * XQ_P + lane * 8) = o; }
                    { const float v0 = bflo(dw[u]), v1 = bfhi(dw[u]); *(LAS unsigned*)(lds + XKV_OFF + (wave * 8 + i0 + u) * XKV_P + lane * 4) = pk2(v0 * rk[u] * kng.x, v1 * rk[u] * kng.y); }
                    { float v[8]; float ss = 0.f;
#pragma unroll
                      for (int e = 0; e < 4; ++e) { v[2 * e] = bflo(qw[u][e]); v[2 * e + 1] = bfhi(qw[u][e]); ss += v[2 * e] * v[2 * e] + v[2 * e + 1] * v[2 * e + 1]; }
                      const float rstd = 1.0f / sqrtf(sum8(ss) * (1.0f / 64.0f) + EPS); u32x4 o;
#pragma unroll
                      for (int e = 0; e < 4; ++e) o[e] = pk2(v[2 * e] * rstd * mqg[2 * e], v[2 * e + 1] * rstd * mqg[2 * e + 1]);
                      *(u32x4*)(zr + ZC_QB + 8 * lane) = o; }
                    { float v[8]; float ss = 0.f;
#pragma unroll
                      for (int e = 0; e < 4; ++e) { v[2 * e] = bflo(kw[u][e]); v[2 * e + 1] = bfhi(kw[u][e]); ss += v[2 * e] * v[2 * e] + v[2 * e + 1] * v[2 * e + 1]; }
                      const float rstd = 1.0f / sqrtf(sum8(ss) * (1.0f / 64.0f) + EPS); u32x4 o;
#pragma unroll
                      for (int e = 0; e < 8; ++e) { v[e] = v[e] * rstd * mkg[e]; kacc[e] += v[e]; }
#pragma unroll
                      for (int e = 0; e < 4; ++e) o[e] = pk2(v[2 * e], v[2 * e + 1]);
                      *(LAS u32x4*)(stg + (wave * 8 + i0 + u) * SROW + lane * 16) = o; }
                }
            }
#pragma unroll
            for (int e = 0; e < 8; ++e) red[wave * 512 + lane * 8 + e] = kacc[e];
            __syncthreads();
            { float sm = 0.f;
#pragma unroll
              for (int w = 0; w < 8; ++w) sm += red[w * 512 + tid];
              kpart[(size_t)bx * 512 + tid] = sm; }
#pragma unroll
            for (int pi = 0; pi < 8; ++pi) { const int p = wave * 8 + pi, ktl = p >> 5, h = (p >> 2) & 7, d0 = p & 3;
                const u32x4 v = *(const LAS u32x4*)(stg + (32 * ktl + r32) * SROW + (h * 64 + d0 * 16 + hi * 8) * 2);
                const int kt = s0 / 32 + ktl;
                store16_wt(KFb + ((((size_t)(b * 8 + h) * 256 + kt) * 4 + d0) * 64 + lane) * 8, v); }
            __syncthreads();
#pragma unroll
            for (int i = 0; i < 8; ++i) *(LAS u32x4*)(stg + (wave * 8 + i) * SROW + lane * 16) = vrow[i];
            *(LAS f32x4*)(lds + ROPE_L + (tid >> 3) * ROPE_P + (tid & 7) * 16) = rope_pf;
            if (tid < 256) *(LAS u32x4*)(lds + KR_L + (tid >> 2) * KR_P + (tid & 3) * 16) = kr_pf;
            __syncthreads();
#pragma unroll
            for (int pi = 0; pi < 8; ++pi) { const int p = wave * 8 + pi, ksl = p >> 4, h = (p >> 1) & 7, dh = p & 1;
                const LAS unsigned char* cp = stg + (16 * ksl + 4 * hi) * SROW + (h * 64 + 32 * dh + r32) * 2;
                unsigned e[8];
#pragma unroll
                for (int j = 0; j < 8; ++j) e[j] = *(const LAS unsigned short*)(cp + ((j & 3) + 8 * (j >> 2)) * SROW);
                u32x4 w; w.x = e[0] | (e[1] << 16); w.y = e[2] | (e[3] << 16); w.z = e[4] | (e[5] << 16); w.w = e[6] | (e[7] << 16);
                const int ks = s0 / 16 + ksl;
                store16_wt(VFb + ((((size_t)(b * 8 + h) * 512 + ks) * 2 + dh) * 64 + lane) * 8, w); }
            __syncthreads();
            {
                const int h = wave, row0 = bx * 64;
                LAS unsigned char* ost = lds + wave * OST_W;
                const LAS unsigned char* xq = lds + XQ_OFF + r32 * XQ_P + hi * 16; const LAS unsigned char* xkv = lds + XKV_OFF + r32 * XKV_P + hi * 16;
                const LAS float* gqL = (const LAS float*)(lds + GQ_OFF); const LAS float* gkL = (const LAS float*)(lds + GK_OFF);
                const u32x4* wk = (const u32x4*)(WL + W_UKV) + (size_t)h * 1024 + lane; const u32x4* wv = (const u32x4*)(WL + W_UKV) + (size_t)(8 + h) * 1024 + lane;
                u32x4 ak[8][2], av[8][2];
                const LAS unsigned char* ropeL = lds + ROPE_L + r32 * ROPE_P; const LAS unsigned char* krL = lds + KR_L + r32 * KR_P;
                {
                    const u32x4* wq = (const u32x4*)(WL + W_UQ) + (size_t)h * 3072 + lane;
                    f32x16 acc[2][3];
#pragma unroll
                    for (int tb = 0; tb < 2; ++tb)
#pragma unroll
                        for (int nb = 0; nb < 3; ++nb) acc[tb][nb] = f32x16{};
                    u32x4 a[8][3];
#pragma unroll
                    for (int s_ = 0; s_ < 8; ++s_)
#pragma unroll
                        for (int nb = 0; nb < 3; ++nb) a[s_][nb] = wq[(s_ * 3 + nb) * 64];
                    SBAR();
#pragma unroll
                    for (int ks = 0; ks < 16; ++ks) {
                        bf16x8 bq[2];
#pragma unroll
                        for (int tb = 0; tb < 2; ++tb) bq[tb] = *(const LAS bf16x8*)(xq + tb * 32 * XQ_P + ks * 32);
#pragma unroll
                        for (int nb = 0; nb < 3; ++nb)
#pragma unroll
                            for (int tb = 0; tb < 2; ++tb) acc[tb][nb] = __builtin_amdgcn_mfma_f32_32x32x16_bf16(__builtin_bit_cast(bf16x8, a[ks & 7][nb]), bq[tb], acc[tb][nb], 0, 0, 0);
                        if (ks + 8 < 16) {
#pragma unroll
                            for (int nb = 0; nb < 3; ++nb) a[ks & 7][nb] = wq[((ks + 8) * 3 + nb) * 64]; }
                        SBAR();
                    }
#pragma unroll
                    for (int ks = 0; ks < 8; ++ks)
#pragma unroll
                        for (int nb = 0; nb < 2; ++nb) ak[ks][nb] = wk[(ks * 2 + nb) * 64];
                    SBAR();
#pragma unroll
                    for (int tb = 0; tb < 2; ++tb) {
                        const size_t row = (size_t)row0 + tb * 32 + r32;
                        float ss = 0.f;
#pragma unroll
                        for (int nb = 0; nb < 3; ++nb)
#pragma unroll
                            for (int r = 0; r < 16; ++r) ss += acc[tb][nb][r] * acc[tb][nb][r];
                        { auto rr = __builtin_amdgcn_permlane32_swap(__float_as_uint(ss), __float_as_uint(ss), false, false); ss = __uint_as_float(rr[0]) + __uint_as_float(rr[1]); }
                        const float rstd = QSCALE_A / sqrtf(ss * (1.0f / 96.0f) + EPS);
#pragma unroll
                        for (int nb = 0; nb < 2; ++nb)
#pragma unroll
                            for (int i = 0; i < 4; ++i) { const int n0 = nb * 32 + 8 * i + 4 * hi; const f32x4 g4 = *(const LAS f32x4*)(gqL + n0);
                                u32x2 o; o.x = pk2(acc[tb][nb][4 * i] * rstd * g4.x, acc[tb][nb][4 * i + 1] * rstd * g4.y); o.y = pk2(acc[tb][nb][4 * i + 2] * rstd * g4.z, acc[tb][nb][4 * i + 3] * rstd * g4.w);
                                *(LAS u32x2*)(ost + r32 * 208 + n0 * 2) = o; }
#pragma unroll
                        for (int i = 0; i < 2; ++i) { const int f0 = 8 * i + 4 * hi;
                            const f32x4 cs = *(const LAS f32x4*)(ropeL + tb * 32 * ROPE_P + f0 * 4), sn = *(const LAS f32x4*)(ropeL + tb * 32 * ROPE_P + 64 + f0 * 4);
                            const f32x4 g1 = *(const LAS f32x4*)(gqL + 64 + f0), g2 = *(const LAS f32x4*)(gqL + 80 + f0);
                            float o1[4], o2[4];
#pragma unroll
                            for (int j = 0; j < 4; ++j) { const float x1 = acc[tb][2][4 * i + j] * rstd * g1[j], x2 = acc[tb][2][4 * (i + 2) + j] * rstd * g2[j];
                                o1[j] = x1 * cs[j] - x2 * sn[j]; o2[j] = x1 * sn[j] + x2 * cs[j]; }
                            u32x2 w1, w2; w1.x = pk2(o1[0], o1[1]); w1.y = pk2(o1[2], o1[3]); w2.x = pk2(o2[0], o2[1]); w2.y = pk2(o2[2], o2[3]);
                            *(LAS u32x2*)(ost + r32 * 208 + (64 + f0) * 2) = w1; *(LAS u32x2*)(ost + r32 * 208 + (80 + f0) * 2) = w2; }
                        LDS_WAIT();
#pragma unroll
                        for (int k = 0; k < 6; ++k) { const int idx = lane + 64 * k, t = idx / 12, c = idx % 12;
                            const u32x4 v = *(const LAS u32x4*)(ost + t * 208 + c * 16);
                            *(u32x4*)(Qb + ((size_t)row0 + tb * 32 + t) * NQ + 96 * h + 8 * c) = v; }
                        LDS_WAIT();
                    }
                }
                {
                    f32x16 acc[2][2];
#pragma unroll
                    for (int tb = 0; tb < 2; ++tb)
#pragma unroll
                        for (int nb = 0; nb < 2; ++nb) acc[tb][nb] = f32x16{};
#pragma unroll
                    for (int ks = 0; ks < 8; ++ks) {
                        bf16x8 bq[2];
#pragma unroll
                        for (int tb = 0; tb < 2; ++tb) bq[tb] = *(const LAS bf16x8*)(xkv + tb * 32 * XKV_P + ks * 32);
#pragma unroll
                        for (int nb = 0; nb < 2; ++nb)
#pragma unroll
                            for (int tb = 0; tb < 2; ++tb) acc[tb][nb] = __builtin_amdgcn_mfma_f32_32x32x16_bf16(__builtin_bit_cast(bf16x8, ak[ks][nb]), bq[tb], acc[tb][nb], 0, 0, 0);
                    }
#pragma unroll
                    for (int ks = 0; ks < 8; ++ks)
#pragma unroll
                        for (int nb = 0; nb < 2; ++nb) av[ks][nb] = wv[(ks * 2 + nb) * 64];
                    SBAR();
#pragma unroll
                    for (int tb = 0; tb < 2; ++tb) {
                        const u32x4 kr1 = *(const LAS u32x4*)(krL + tb * 32 * KR_P + 16 * hi), kr2 = *(const LAS u32x4*)(krL + tb * 32 * KR_P + 32 + 16 * hi);
                        float x1[8], x2[8]; float ss = 0.f;
#pragma unroll
                        for (int e = 0; e < 4; ++e) { x1[2 * e] = bflo(kr1[e]); x1[2 * e + 1] = bfhi(kr1[e]); x2[2 * e] = bflo(kr2[e]); x2[2 * e + 1] = bfhi(kr2[e]); }
#pragma unroll
                        for (int e = 0; e < 8; ++e) ss += x1[e] * x1[e] + x2[e] * x2[e];
#pragma unroll
                        for (int nb = 0; nb < 2; ++nb)
#pragma unroll
                            for (int r = 0; r < 16; ++r) ss += acc[tb][nb][r] * acc[tb][nb][r];
                        { auto rr = __builtin_amdgcn_permlane32_swap(__float_as_uint(ss), __float_as_uint(ss), false, false); ss = __uint_as_float(rr[0]) + __uint_as_float(rr[1]); }
                        const float rstd = 1.0f / sqrtf(ss * (1.0f / 96.0f) + EPS);
#pragma unroll
                        for (int nb = 0; nb < 2; ++nb)
#pragma unroll
                            for (int i = 0; i < 4; ++i) { const int n0 = nb * 32 + 8 * i + 4 * hi; const f32x4 g4 = *(const LAS f32x4*)(gkL + n0);
                                u32x2 o; o.x = pk2(acc[tb][nb][4 * i] * rstd * g4.x, acc[tb][nb][4 * i + 1] * rstd * g4.y); o.y = pk2(acc[tb][nb][4 * i + 2] * rstd * g4.z, acc[tb][nb][4 * i + 3] * rstd * g4.w);
                                *(LAS u32x2*)(ost + r32 * 208 + n0 * 2) = o; }
                        { float o1[8], o2[8];
#pragma unroll
                          for (int q4 = 0; q4 < 2; ++q4) { const int f0 = 8 * hi + 4 * q4;
                              const f32x4 cs = *(const LAS f32x4*)(ropeL + tb * 32 * ROPE_P + f0 * 4), sn = *(const LAS f32x4*)(ropeL + tb * 32 * ROPE_P + 64 + f0 * 4);
                              const f32x4 g1 = *(const LAS f32x4*)(gkL + 64 + f0), g2 = *(const LAS f32x4*)(gkL + 80 + f0);
#pragma unroll
                              for (int j = 0; j < 4; ++j) { const float y1 = x1[4 * q4 + j] * rstd * g1[j], y2 = x2[4 * q4 + j] * rstd * g2[j];
                                  o1[4 * q4 + j] = y1 * cs[j] - y2 * sn[j]; o2[4 * q4 + j] = y1 * sn[j] + y2 * cs[j]; } }
                          u32x4 w1, w2;
#pragma unroll
                          for (int e = 0; e < 4; ++e) { w1[e] = pk2(o1[2 * e], o1[2 * e + 1]); w2[e] = pk2(o2[2 * e], o2[2 * e + 1]); }
                          *(LAS u32x4*)(ost + r32 * 208 + (64 + 8 * hi) * 2) = w1; *(LAS u32x4*)(ost + r32 * 208 + (80 + 8 * hi) * 2) = w2; }
                        LDS_WAIT();
#pragma unroll
                        for (int k = 0; k < 6; ++k) { const int idx = lane + 64 * k, t = idx / 12, c = idx % 12;
                            const u32x4 v = *(const LAS u32x4*)(ost + t * 208 + c * 16);
                            *(u32x4*)(Kb + ((size_t)row0 + tb * 32 + t) * NQ + 96 * h + 8 * c) = v; }
                        LDS_WAIT();
                    }
                }
                {
                    f32x16 acc[2][2];
#pragma unroll
                    for (int tb = 0; tb < 2; ++tb)
#pragma unroll
                        for (int nb = 0; nb < 2; ++nb) acc[tb][nb] = f32x16{};
#pragma unroll
                    for (int ks = 0; ks < 8; ++ks) {
                        bf16x8 bq[2];
#pragma unroll
                        for (int tb = 0; tb < 2; ++tb) bq[tb] = *(const LAS bf16x8*)(xkv + tb * 32 * XKV_P + ks * 32);
#pragma unroll
                        for (int nb = 0; nb < 2; ++nb)
#pragma unroll
                            for (int tb = 0; tb < 2; ++tb) acc[tb][nb] = __builtin_amdgcn_mfma_f32_32x32x16_bf16(__builtin_bit_cast(bf16x8, av[ks][nb]), bq[tb], acc[tb][nb], 0, 0, 0);
                    }
#pragma unroll
                    for (int tb = 0; tb < 2; ++tb) {
#pragma unroll
                        for (int nb = 0; nb < 2; ++nb)
#pragma unroll
                            for (int i = 0; i < 4; ++i) { const int n0 = nb * 32 + 8 * i + 4 * hi;
                                u32x2 o; o.x = pk2(acc[tb][nb][4 * i], acc[tb][nb][4 * i + 1]); o.y = pk2(acc[tb][nb][4 * i + 2], acc[tb][nb][4 * i + 3]);
                                *(LAS u32x2*)(ost + r32 * 144 + n0 * 2) = o; }
                        LDS_WAIT();
#pragma unroll
                        for (int k = 0; k < 4; ++k) { const int idx = lane + 64 * k, t = idx >> 3, c = idx & 7;
                            const u32x4 v = *(const LAS u32x4*)(ost + t * 144 + c * 16);
                            *(u32x4*)(KVb + ((size_t)row0 + tb * 32 + t) * NKV + 128 * h + 64 + 8 * c) = v; }
                        LDS_WAIT();
                    }
                }
            }
            __syncthreads();
        }
        SEAM(P + 2);
        if (IN(P + 3)) { PH_ARGS const int tid = launder(tidx()), lane = tid & 63; (void)lane;
            float gq = fabsf(Ap->mq_g[l * 64 + lane]), gk = fabsf(Ap->mk_g[l * 64 + lane]), bm = 0.f;
            const int xg = bx & 7;
#pragma unroll
            for (int o_ = 1; o_ < 32; o_ <<= 1) { gq = fmaxf(gq, swz_xor_dyn(gq, o_)); gk = fmaxf(gk, swz_xor_dyn(gk, o_)); }
            { auto rr = __builtin_amdgcn_permlane32_swap(__float_as_uint(gq), __float_as_uint(gq), false, false); gq = fmaxf(__uint_as_float(rr[0]), __uint_as_float(rr[1])); }
            { auto rr = __builtin_amdgcn_permlane32_swap(__float_as_uint(gk), __float_as_uint(gk), false, false); gk = fmaxf(__uint_as_float(rr[0]), __uint_as_float(rr[1])); }
            const float gqk = __builtin_bit_cast(float, __builtin_amdgcn_readfirstlane(__builtin_bit_cast(int, 8.0f * gq * gk)));
            unsigned* qctr = ctl + CW_Q + (l * 8 + xg) * 64;
            if (tidx() == 0) MISC[16] = __hip_atomic_fetch_add(qctr, 1u, __ATOMIC_RELAXED, __HIP_MEMORY_SCOPE_AGENT);
            for (;;) {
                __syncthreads();
                const unsigned ui = MISC[16];
                __syncthreads();
                if (ui >= 128u) break;
                const int type = (int)(ui >> 6), r = (int)(ui & 63u), qb = 31 - (r >> 1), bh = 2 * xg + (r & 1), b = bh >> 3, h = bh & 7;
                if (type == 0) { att::Tens T{Qb + 96 * h, NQ, Kb + 96 * h, NQ, KVb + 128 * h + 64, NKV, Zb + ZC_GMLA + 64 * h, ZP, Zb + ZC_AO + 64 * h, ZP, 0.f};
                    att::unit<6>(T, b, qb, (LAS char*)lds, qctr, MISC + 16); }
                else {
                    bm = 0.f; { const int ln = launder(tidx()) & 31; const float v = fabsf(Ap->rel_bias[ln * 8 + h]); bm = v;
#pragma unroll
                      for (int o_ = 1; o_ < 32; o_ <<= 1) bm = fmaxf(bm, swz_xor_dyn(bm, o_));
                      auto rr = __builtin_amdgcn_permlane32_swap(__float_as_uint(bm), __float_as_uint(bm), false, false); bm = fmaxf(__uint_as_float(rr[0]), __uint_as_float(rr[1])); }
                    const float Bshift = fminf((gqk + bm) * LOG2E, 40.0f);
                    moba::Tens T{Zb + ZC_QB + 64 * h, ZP, Zb + ZC_GMOBA + 64 * h, ZP, Zb + ZC_AO + 512 + 64 * h, ZP, kpart, biasT + h * 8192, (const bf16_t*)(ws + WS_KF), (const bf16_t*)(ws + WS_VF), Bshift};
                    moba::unit(T, b, h, qb, (LAS char*)lds, qctr, MISC + 16); }
            }
        }
        SEAM(P + 3);
        if (IN(P + 4)) { PH_ARGS
            pg8::Gemm g{Zb + ZC_AO, (const bf16_t*)(WL + W_OUT), M, DMODEL, DMODEL, ZP, DMODEL}; pg8::StaticOrder S; S.init(M, DMODEL, G, launder_s32(bx));
            pg8::EpiResid E{XIN, Ap->out, DMODEL, modb + (l * 2) * 3072 + 2 * DMODEL, 3072};
            pg8::gemm_phase<pg8::EpiResid>(lds, g, S, E);
        }
        if (l + 1 < DEPTH) SEAM(P + 4);
    }
#undef IN
#undef SEAM
}

constexpr int N_PHASES = 1 + 5 * DEPTH;

extern "C" void kernel_launch(void* const* d_in, const int* in_sizes, int n_in, void* d_out, int out_size, void* d_ws, size_t ws_size, hipStream_t stream) {
    static int ready = 0, one_launch = 0;
    if (ready == 0) {
        if (n_in != 17 || in_sizes[0] != M * DMODEL || out_size != M * DMODEL || ws_size < WS_END) { fprintf(stderr, "kernel_launch: unexpected shapes (n_in %d, in0 %d, out %d, ws %zu)\n", n_in, n_in > 0 ? in_sizes[0] : -1, out_size, ws_size); ready = -1; return; }
        if (hipFuncSetAttribute((const void*)mk_fwd, hipFuncAttributeMaxDynamicSharedMemorySize, LDS_BYTES) != hipSuccess) { fprintf(stderr, "kernel_launch: hipFuncSetAttribute failed\n"); ready = -1; return; }
        int dev = 0, cus = 0, per_cu = 0;
        if (hipGetDevice(&dev) != hipSuccess || hipDeviceGetAttribute(&cus, hipDeviceAttributeMultiprocessorCount, dev) != hipSuccess) cus = 0;
        if (hipOccupancyMaxActiveBlocksPerMultiprocessor(&per_cu, (const void*)mk_fwd, NWAVES * 64, LDS_BYTES) != hipSuccess) per_cu = 0;
        (void)hipGetLastError();
        one_launch = (MK_ONE_LAUNCH && (long)cus * (long)per_cu >= 256) ? 1 : 0;
        if (!one_launch) fprintf(stderr, "kernel_launch: %d CUs x %d resident workgroups < 256: falling back to one launch per phase\n", cus, per_cu);
        ready = 1;
    }
    if (ready < 0) return;
    (void)hipMemsetAsync((char*)d_ws + WS_CTL, 0, CTL_ZERO_BYTES, stream);
    Args a{};
    a.x = (const float*)d_in[0]; a.c = (const float*)d_in[1]; a.pos = (const int*)d_in[2]; a.norm_g = (const float*)d_in[3]; a.w_ada = (const float*)d_in[4]; a.b_ada = (const float*)d_in[5];
    a.w_in = (const float*)d_in[6]; a.q_norm_g = (const float*)d_in[7]; a.w_uq = (const float*)d_in[8]; a.kv_norm_g = (const float*)d_in[9]; a.w_ukv = (const float*)d_in[10];
    a.q_g = (const float*)d_in[11]; a.k_g = (const float*)d_in[12]; a.mq_g = (const float*)d_in[13]; a.mk_g = (const float*)d_in[14]; a.w_out = (const float*)d_in[15]; a.rel_bias = (const float*)d_in[16];
    a.out = (float*)d_out; a.ws = (unsigned char*)d_ws;
    const int grid = 256;
    if (one_launch) { a.ph_lo = 0; a.ph_hi = N_PHASES; hipLaunchKernelGGL(mk_fwd, dim3(grid), dim3(NWAVES * 64), LDS_BYTES, stream, a); }
    else for (int p = 0; p < N_PHASES; ++p) { a.ph_lo = p; a.ph_hi = p + 1; hipLaunchKernelGGL(mk_fwd, dim3(grid), dim3(NWAVES * 64), LDS_BYTES, stream, a); }
}
```

```cpp
#include <hip/hip_runtime.h>
#include <hip/hip_bf16.h>
#include <cstdio>
#include <cstdint>
#include <cmath>

#ifndef MK_ONE_LAUNCH
#define MK_ONE_LAUNCH 1
#endif

#define LAS __attribute__((address_space(3)))
#define GAS __attribute__((address_space(1)))
typedef unsigned short bf16_t;
typedef short bf16x8 __attribute__((ext_vector_type(8)));
typedef short s16x4 __attribute__((ext_vector_type(4)));
typedef float f32x4 __attribute__((ext_vector_type(4)));
typedef float f32x2 __attribute__((ext_vector_type(2)));
typedef float f32x16 __attribute__((ext_vector_type(16)));
typedef unsigned u32x4 __attribute__((ext_vector_type(4)));
typedef unsigned u32x2 __attribute__((ext_vector_type(2)));

constexpr int BATCH = 2, SEQ = 8192, DMODEL = 1024, DEPTH = 2;
constexpr int M = BATCH * SEQ;
constexpr int D_IN = 2976, ZP = 3072;
constexpr int ZC_CQ = 0, ZC_CKV = 256, ZC_KROPE = 384, ZC_GMLA = 512, ZC_QB = 1024, ZC_KB = 1536, ZC_VB = 2048, ZC_GMOBA = 2560;
constexpr int QLORA = 256, KVLORA = 128, NQ = 768, NKV = 1024;
constexpr float EPS = 1e-6f;
constexpr float LOG2E = 1.4426950408889634f;
constexpr float QSCALE_A = 0.10206207261596577f * LOG2E;
constexpr float QSCALE_B = 0.125f * LOG2E;

constexpr size_t MiB = 1u << 20;
constexpr size_t WS_CTL = 0, CTL_ZERO_BYTES = 1 * MiB;
constexpr size_t WS_W = 2 * MiB, W_LAYER = 10 * MiB;
constexpr size_t W_IN = 0, W_OUT = 6 * MiB, W_UQ = 8 * MiB, W_UKV = 9 * MiB;
constexpr size_t WS_MOD = 22 * MiB;
constexpr size_t WS_BIAS = 22 * MiB + 64 * 1024;
constexpr size_t WS_KPART = 22 * MiB + 512 * 1024;
constexpr size_t WS_ROPE = 24 * MiB;
constexpr size_t WS_IMG = 26 * MiB;
constexpr size_t WS_Z = 58 * MiB;
constexpr size_t WS_Q = 154 * MiB;
constexpr size_t WS_KV = 178 * MiB;
constexpr size_t WS_H = WS_KV;
constexpr size_t WS_K = 210 * MiB;
constexpr size_t WS_KF = WS_IMG, WS_VF = WS_IMG + 16 * MiB;
constexpr size_t WS_END = 234 * MiB;
constexpr int CW_BAR = 4096, CW_Q = 16384, CW_PANEL = 20480, CW_PCNT = 22528, CW_FDONE = 24576;
static_assert(CW_BAR + 3456 <= CW_Q && CW_Q + 16 * 64 <= CW_PANEL && CW_PANEL + 64 * 16 <= CW_PCNT && CW_PCNT + 2 * 64 * 16 <= CW_FDONE && (CW_FDONE + 2 * 16) * 4 <= (int)CTL_ZERO_BYTES, "control words");
constexpr int ZC_AO = 1536;

__device__ __forceinline__ unsigned f2bf(float f) { unsigned u = __builtin_bit_cast(unsigned, f); return (u + 0x7fffu + ((u >> 16) & 1u)) >> 16; }
__device__ __forceinline__ unsigned pk2(float lo, float hi) { typedef __bf16 bf16x2_t __attribute__((ext_vector_type(2))); f32x2 v = {lo, hi}; return __builtin_bit_cast(unsigned, __builtin_convertvector(v, bf16x2_t)); }
__device__ __forceinline__ float bflo(unsigned w) { return __builtin_bit_cast(float, w << 16); }
__device__ __forceinline__ float bfhi(unsigned w) { return __builtin_bit_cast(float, w & 0xffff0000u); }
template <int X> __device__ __forceinline__ float swz_xor(float v) { return __builtin_bit_cast(float, __builtin_amdgcn_ds_swizzle(__builtin_bit_cast(int, v), (X << 10) | 0x1f)); }
__device__ __forceinline__ float swz_xor_dyn(float v, int x) {
    switch (x) { case 1: return swz_xor<1>(v); case 2: return swz_xor<2>(v); case 4: return swz_xor<4>(v); case 8: return swz_xor<8>(v); default: return swz_xor<16>(v); } }
template <int CTRL, int ROWMASK> __device__ __forceinline__ float dpp_mov(float v) { return __builtin_bit_cast(float, __builtin_amdgcn_update_dpp(0, __builtin_bit_cast(int, v), CTRL, ROWMASK, 0xF, false)); }
__device__ __forceinline__ float sum8(float v) { v += dpp_mov<0xB1, 0xF>(v); v += dpp_mov<0x4E, 0xF>(v); v += dpp_mov<0x141, 0xF>(v); return v; }
__device__ __forceinline__ float wave_sum(float v) {
    v = sum8(v); v += dpp_mov<0x140, 0xF>(v); v += dpp_mov<0x142, 0xA>(v); v += dpp_mov<0x143, 0xC>(v);
    return __builtin_bit_cast(float, __builtin_amdgcn_readlane(__builtin_bit_cast(int, v), 63));
}
__device__ __forceinline__ float wave_max_nn(float v) {
    v = fmaxf(v, dpp_mov<0xB1, 0xF>(v)); v = fmaxf(v, dpp_mov<0x4E, 0xF>(v)); v = fmaxf(v, dpp_mov<0x141, 0xF>(v)); v = fmaxf(v, dpp_mov<0x140, 0xF>(v));
    v = fmaxf(v, dpp_mov<0x142, 0xA>(v)); v = fmaxf(v, dpp_mov<0x143, 0xC>(v));
    return __builtin_bit_cast(float, __builtin_amdgcn_readlane(__builtin_bit_cast(int, v), 63));
}
__device__ __forceinline__ const void* launder_s(const void* p) { asm volatile("" : "+s"(p)); return p; }
constexpr unsigned WTAB_LDS = 143360 + 320 + 128;
__device__ __forceinline__ int hw_slot() { return (int)(__builtin_amdgcn_s_getreg((5 << 11) | 4) & 63u); }
__device__ __forceinline__ int tidx() {
    const unsigned w = ((volatile LAS unsigned*)(size_t)WTAB_LDS)[hw_slot()];
    int lane_; asm volatile("v_mbcnt_lo_u32_b32 %0, -1, 0\n\tv_mbcnt_hi_u32_b32 %0, -1, %0" : "=v"(lane_));
    return (int)((unsigned)__builtin_amdgcn_readfirstlane((int)w) << 6) | lane_;
}
template <class V> __device__ __forceinline__ void store16_wt(void* p, V v) { static_assert(sizeof(V) == 16, "16-byte payload");
    asm volatile("global_store_dwordx4 %0, %1, off sc1\n\ts_nop 1" :: "v"(p), "v"(v) : "memory"); }
__device__ __forceinline__ int launder_s32(int v) { asm volatile("" : "+s"(v)); return v; }
__device__ __forceinline__ int launder(int v) { asm volatile("" : "+v"(v)); return v; }
#define LDS_WAIT() asm volatile("s_waitcnt lgkmcnt(0)" ::: "memory")
#define VM_WAIT() asm volatile("s_waitcnt vmcnt(0)" ::: "memory")

namespace pg8 {
constexpr int BM = 256, BK = 64, HALF = 128, HTB = HALF * BK * 2, STAGE_BYTES = 8 * HTB, NXCD = 8, WGM = 8;
__host__ __device__ __forceinline__ int lds_byte(int r, int c) { const int st = (r >> 4) * 2 + (c >> 5), rr = r & 15, cc = c & 31, ob = rr * 64 + cc * 2; return st * 1024 + (ob ^ (((ob >> 9) & 1) << 5)); }
__host__ __device__ __forceinline__ void stage_rc(int b, int& R, int& C) { const int st = b / 1024, sb = b % 1024, swz = sb ^ (((sb >> 9) & 1) << 5); R = (st >> 1) * 16 + swz / 64; C = (st & 1) * 32 + (swz % 64) / 2; }
__host__ __device__ __forceinline__ int perm32(int rho) { const int n = rho >> 4, i = rho & 15; return 8 * (i >> 2) + 4 * n + (i & 3); }
struct Unit { int pm, pn; };
struct Gemm { const bf16_t* A; const bf16_t* Bt; int M, N, K, lda, ldb; };
struct StaticOrder {
    int nM, nN, nwg, G, c;
    __device__ void init(int M_, int N_, int G_, int c_) { nM = M_ / BM; nN = N_ / BM; nwg = nM * nN; G = G_; c = c_; }
    __device__ bool next(int i, Unit& u) const {
        const long L = (long)i * G + c; if (L >= nwg) return false;
        int wgid = (int)L; { const int q = nwg / NXCD, r = nwg % NXCD, xcd = wgid % NXCD, off = wgid / NXCD; wgid = (xcd < r ? xcd * (q + 1) : r * (q + 1) + (xcd - r) * q) + off; }
        const int nig = WGM * nN, gid = wgid / nig, fm = gid * WGM, gsz = (nM - fm) < WGM ? (nM - fm) : WGM;
        u.pm = fm + ((wgid % nig) % gsz); u.pn = (wgid % nig) / gsz; return true;
    }
};
struct PanelOrder {
    int pm, pn0, per;
    __device__ void init(int bx_, int per_) { pm = bx_ >> 2; pn0 = (bx_ & 3) * per_; per = per_; }
    __device__ bool next(int i, Unit& u) const { if (i >= per) return false; u.pm = pm; u.pn = pn0 + i; return true; }
};
__device__ __forceinline__ unsigned cvt_pk_bf16(float lo, float hi) { unsigned r; asm volatile("v_cvt_pk_bf16_f32 %0, %1, %2" : "=v"(r) : "v"(lo), "v"(hi)); return r; }

struct EpiBf16 {
    static constexpr bool PERM = true;
    bf16_t* O; int ldc;
    __device__ __forceinline__ void operator()(const f32x4 (&acc)[2][2][4][2], const Unit& u, int wr, int wc, int fr, int fq) const {
        const int row0 = u.pm * BM + wr * 64 + fr; const int col0 = u.pn * BM + wc * 32 + 8 * fq;
#pragma unroll
        for (int ai = 0; ai < 2; ++ai)
#pragma unroll
            for (int m = 0; m < 4; ++m) { bf16_t* rowp = O + (size_t)(row0 + ai * HALF + m * 16) * ldc + col0;
#pragma unroll
                for (int bj = 0; bj < 2; ++bj) { const f32x4 v0 = acc[ai][bj][m][0], v1 = acc[ai][bj][m][1];
                    u32x4 w; w.x = cvt_pk_bf16(v0[0], v0[1]); w.y = cvt_pk_bf16(v0[2], v0[3]); w.z = cvt_pk_bf16(v1[0], v1[1]); w.w = cvt_pk_bf16(v1[2], v1[3]);
                    store16_wt(rowp + bj * HALF, w); } }
    }
};
struct EpiResid {
    static constexpr bool PERM = false;
    const float* xin; float* out; int ldc; const float* gate0; int gstride;
    __device__ __forceinline__ void operator()(const f32x4 (&acc)[2][2][4][2], const Unit& u, int wr, int wc, int fr, int fq) const {
        const int col0 = u.pn * BM + wc * 32 + 4 * fq; const float* gate = gate0 + (size_t)((u.pm * BM) / SEQ) * gstride;
        f32x4 gv[2][2];
#pragma unroll
        for (int bj = 0; bj < 2; ++bj)
#pragma unroll
            for (int n = 0; n < 2; ++n) gv[bj][n] = *(const f32x4*)(gate + col0 + bj * HALF + n * 16);
#pragma unroll
        for (int ai = 0; ai < 2; ++ai) {
            f32x4 xi[4][2][2];
#pragma unroll
            for (int m = 0; m < 4; ++m) { const size_t off = (size_t)(u.pm * BM + ai * HALF + wr * 64 + m * 16 + fr) * ldc + col0;
#pragma unroll
                for (int bj = 0; bj < 2; ++bj)
#pragma unroll
                    for (int n = 0; n < 2; ++n) xi[m][bj][n] = *(const f32x4*)(xin + off + bj * HALF + n * 16); }
#pragma unroll
            for (int m = 0; m < 4; ++m) { const size_t off = (size_t)(u.pm * BM + ai * HALF + wr * 64 + m * 16 + fr) * ldc + col0;
#pragma unroll
                for (int bj = 0; bj < 2; ++bj)
#pragma unroll
                    for (int n = 0; n < 2; ++n) { const f32x4 ov = xi[m][bj][n] + gv[bj][n] * acc[ai][bj][m][n]; store16_wt(out + off + bj * HALF + n * 16, ov); } }
        }
    }
};

template <class Epi, class Ord, bool ALIGN_EPI = true>
__device__ __forceinline__ void gemm_phase(LAS unsigned char* lds, const Gemm g, const Ord& S, const Epi& E) {
    const int tid = launder(tidx()), wid = __builtin_amdgcn_readfirstlane(tid >> 6), lane = tid & 63, wr = wid >> 2, wc = wid & 3, fr = lane & 15, fq = lane >> 4;
    const int K = g.K, nt = K / BK;
    unsigned voffA[2], voffB[2];
#pragma unroll
    for (int i = 0; i < 2; ++i) { int R, C; stage_rc(tid * 16 + i * 8192, R, C); const int Rb = Epi::PERM ? ((R & ~31) + perm32(R & 31)) : R;
        voffA[i] = (unsigned)(R * g.lda + C) * 2u; voffB[i] = (unsigned)(Rb * g.ldb + C) * 2u; }
    const size_t kstep = (size_t)(BK * 2);
    const size_t hstepA = (size_t)HALF * g.lda * 2, hstepB = (size_t)HALF * g.ldb * 2;
    const size_t tstepA = 2 * hstepA, tstepB = 2 * hstepB;
    const unsigned ldsw = (unsigned)wid * 1024u;
    const int aoff = lds_byte(wr * 64 + fr, fq * 8), boff = lds_byte(wc * 32 + fr, fq * 8);
#define PG8_SA(b, h) (((b) * 2 + (h)) * HTB)
#define PG8_SB(b, h) ((4 + (b) * 2 + (h)) * HTB)
#define PG8_STAGE(bufoff, gbase, voff) do { _Pragma("unroll") for (int _i = 0; _i < 2; ++_i) \
        __builtin_amdgcn_global_load_lds((const unsigned*)((const char*)(gbase) + (voff)[_i]), (LAS unsigned*)(lds + (bufoff) + ldsw + _i * 8192), 16, 0, 0); } while (0)
#define PG8_LDA(dst, b, h) do { _Pragma("unroll") for (int m = 0; m < 4; ++m) _Pragma("unroll") for (int k = 0; k < 2; ++k) dst[m][k] = *(const LAS bf16x8*)(lds + PG8_SA(b, h) + aoff + m * 2048 + k * 1024); } while (0)
#define PG8_LDB(dst, b, h) do { _Pragma("unroll") for (int n = 0; n < 2; ++n) _Pragma("unroll") for (int k = 0; k < 2; ++k) dst[n][k] = *(const LAS bf16x8*)(lds + PG8_SB(b, h) + boff + n * 2048 + k * 1024); } while (0)
#define PG8_MMA(ai, bj, At, Bt) do { __builtin_amdgcn_s_setprio(1); _Pragma("unroll") for (int m = 0; m < 4; ++m) _Pragma("unroll") for (int n = 0; n < 2; ++n) _Pragma("unroll") for (int k = 0; k < 2; ++k) \
        acc[ai][bj][m][n] = __builtin_amdgcn_mfma_f32_16x16x32_bf16(Bt[n][k], At[m][k], acc[ai][bj][m][n], 0, 0, 0); __builtin_amdgcn_s_setprio(0); } while (0)
#define PG8_WAIT_V(n) asm volatile("s_waitcnt vmcnt(" #n ")" ::: "memory")
#define PG8_WAIT_L(n) asm volatile("s_waitcnt lgkmcnt(" #n ")" ::: "memory")
#define PG8_BAR __builtin_amdgcn_s_barrier()
#define PG8_SCHED __builtin_amdgcn_sched_barrier(0)
    Unit cur, nxt; int ui = 0;
    if (!S.next(0, cur)) return;
    f32x4 acc[2][2][4][2];
#pragma unroll
    for (int a = 0; a < 2; ++a)
#pragma unroll
        for (int b = 0; b < 2; ++b)
#pragma unroll
            for (int m = 0; m < 4; ++m)
#pragma unroll
                for (int n = 0; n < 2; ++n) acc[a][b][m][n] = (f32x4){0.f, 0.f, 0.f, 0.f};
    bf16x8 At[4][2], B0[2][2], B1[2][2];
    const char* cA = (const char*)g.A + (size_t)cur.pm * tstepA; const char* cB = (const char*)g.Bt + (size_t)cur.pn * tstepB;
    {
        PG8_STAGE(PG8_SB(0, 0), cB, voffB); PG8_STAGE(PG8_SB(0, 1), cB + hstepB, voffB); PG8_STAGE(PG8_SA(0, 0), cA, voffA); PG8_STAGE(PG8_SA(0, 1), cA + hstepA, voffA);
        if (wr == 1) PG8_BAR;
        PG8_WAIT_V(2); PG8_BAR;
        PG8_STAGE(PG8_SB(1, 0), cB + kstep, voffB); PG8_STAGE(PG8_SA(1, 0), cA + kstep, voffA); PG8_STAGE(PG8_SB(1, 1), cB + hstepB + kstep, voffB);
        PG8_WAIT_V(6); PG8_BAR;
    }
    for (;;) {
        const bool has_next = S.next(ui + 1, nxt);
        const char* nA = has_next ? (const char*)g.A + (size_t)nxt.pm * tstepA : cA; const char* nB = has_next ? (const char*)g.Bt + (size_t)nxt.pn * tstepB : cB;
        for (int t = 0; t < nt; t += 2) {
            const bool last = (t == nt - 2);
            const char* a1 = cA + (size_t)(t + 1) * kstep;
            const char* a2 = last ? nA : cA + (size_t)(t + 2) * kstep; const char* b2 = last ? nB : cB + (size_t)(t + 2) * kstep;
            const char* a3 = a2 + kstep; const char* b3 = b2 + kstep;
            PG8_LDB(B0, 0, 0); PG8_LDB(B1, 0, 1); PG8_SCHED; PG8_LDA(At, 0, 0); PG8_STAGE(PG8_SA(1, 1), a1 + hstepA, voffA);
            PG8_WAIT_V(8); PG8_WAIT_L(0); PG8_BAR; PG8_MMA(0, 0, At, B0); PG8_MMA(0, 1, At, B1); PG8_BAR; PG8_SCHED;
            PG8_LDA(At, 0, 1); PG8_STAGE(PG8_SB(0, 0), b2, voffB); PG8_STAGE(PG8_SB(0, 1), b2 + hstepB, voffB); PG8_STAGE(PG8_SA(0, 0), a2, voffA);
            PG8_WAIT_V(8); PG8_WAIT_L(0); PG8_BAR; PG8_MMA(1, 0, At, B0); PG8_MMA(1, 1, At, B1); PG8_BAR; PG8_SCHED;
            PG8_LDB(B0, 1, 0); PG8_LDB(B1, 1, 1); PG8_SCHED; PG8_LDA(At, 1, 0); PG8_STAGE(PG8_SA(0, 1), a2 + hstepA, voffA);
            PG8_WAIT_V(8); PG8_WAIT_L(0); PG8_BAR; PG8_MMA(0, 0, At, B0); PG8_MMA(0, 1, At, B1); PG8_BAR; PG8_SCHED;
            PG8_LDA(At, 1, 1); PG8_STAGE(PG8_SB(1, 0), b3, voffB); PG8_STAGE(PG8_SB(1, 1), b3 + hstepB, voffB); PG8_STAGE(PG8_SA(1, 0), a3, voffA);
            PG8_WAIT_V(8); PG8_WAIT_L(0); PG8_BAR; PG8_MMA(1, 0, At, B0); PG8_MMA(1, 1, At, B1); PG8_BAR; PG8_SCHED;
        }
        if constexpr (ALIGN_EPI) { if (wr == 0) PG8_BAR; }
        { const int l2 = launder(tidx()) & 63; E(acc, cur, wr, wc, l2 & 15, l2 >> 4); }
        if (!has_next) break;
#pragma unroll
        for (int a = 0; a < 2; ++a)
#pragma unroll
            for (int b = 0; b < 2; ++b)
#pragma unroll
                for (int m = 0; m < 4; ++m)
#pragma unroll
                    for (int n = 0; n < 2; ++n) acc[a][b][m][n] = (f32x4){0.f, 0.f, 0.f, 0.f};
        cur = nxt; cA = nA; cB = nB; ++ui;
        if constexpr (ALIGN_EPI) { if (wr == 1) PG8_BAR; }
    }
    PG8_WAIT_V(0);
    if constexpr (!ALIGN_EPI) { if (wr == 0) PG8_BAR; }
    PG8_BAR;
#undef PG8_SA
#undef PG8_SB
#undef PG8_STAGE
#undef PG8_LDA
#undef PG8_LDB
#undef PG8_MMA
#undef PG8_WAIT_V
#undef PG8_WAIT_L
#undef PG8_BAR
#undef PG8_SCHED
}
}

namespace att {
constexpr int SLOT = 20480, KOFF = 0, VOFF = 12288;
constexpr int L_WSF = 4 * SLOT, L_OST = L_WSF + 2048, OST_W = 32 * 144, L_END = L_OST + 8 * OST_W;
constexpr float THR = 8.f;
__device__ __forceinline__ int crow(int r, int hi) { return (r & 3) + 8 * (r >> 2) + 4 * hi; }
__device__ __forceinline__ void glds16(const void* gsrc, unsigned lds_dst) { unsigned keep;
    asm volatile("s_mov_b32 %0, m0\n\ts_mov_b32 m0, %2\n\ts_nop 0\n\tglobal_load_lds_dwordx4 %1, off\n\ts_mov_b32 m0, %0" : "=&s"(keep) : "v"(gsrc), "s"(lds_dst) : "memory"); }
__device__ __forceinline__ void glds16s(const void* sbase, unsigned voff, unsigned lds_dst) { unsigned keep;
    asm volatile("s_mov_b32 %0, m0\n\ts_mov_b32 m0, %3\n\ts_nop 0\n\tglobal_load_lds_dwordx4 %1, %2\n\ts_mov_b32 m0, %0" : "=&s"(keep) : "v"(voff), "s"(sbase), "s"(lds_dst) : "memory"); }
__device__ __forceinline__ unsigned cvtpk_s(float lo, float hi) { typedef __bf16 bf16x2_t __attribute__((ext_vector_type(2))); f32x2 v = {lo, hi}; bf16x2_t b = __builtin_convertvector(v, bf16x2_t); return __builtin_bit_cast(unsigned, b); }
typedef short v4i16_t __attribute__((ext_vector_type(4)));
__device__ __forceinline__ s16x4 vtr(const LAS char* p) { return __builtin_bit_cast(s16x4, __builtin_amdgcn_ds_read_tr16_b64_v4i16((LAS v4i16_t*)p)); }
#define ATT_WAIT_BAR() asm volatile("s_waitcnt vmcnt(0) lgkmcnt(0)\n\ts_barrier" ::: "memory")
#define MX3(a, b, c) __builtin_fmaxf(__builtin_fmaxf((a), (b)), (c))
#define SBAR() __builtin_amdgcn_sched_barrier(0)
__device__ __forceinline__ int bucket(int d) { if (d < 16) return d; const int b = 39 - __builtin_clz((unsigned)(d * d)); return b > 31 ? 31 : b; }

struct Tens { const bf16_t* Q; int qp; const bf16_t* K; int kp; const bf16_t* V; int vp; const bf16_t* G; int gp; bf16_t* O; int op; float Bshift; };

template <int NKD>
__device__ __forceinline__ void unit(const Tens& T, int b, int qb, LAS char* lds, unsigned* qnext, volatile LAS unsigned* qslot, unsigned* pcb, int pslot, int fslot) {
    const int tid = launder(tidx()), lane = tid & 63, r32 = lane & 31, hi = lane >> 5; const int wid = __builtin_amdgcn_readfirstlane(tid >> 6);
    const bool g1 = wid >= 4;
    const long rowbase = (long)b * SEQ; const int q0 = qb * 256, NT = 4 * qb + 4;
    const int qpos = q0 + wid * 32 + r32;
    const unsigned lds0 = (unsigned)(uintptr_t)lds;
    LAS float* wsf = (LAS float*)(lds + L_WSF) + wid * 64;
    static_assert(NKD == 6, "the counted vmcnt below assumes 5 LDS-DMA pieces per wave and tile");
    const int w4 = wid & 3;
    const unsigned koff = (unsigned)((lane * T.kp + w4 * 8) * 2);
    const unsigned voff = (unsigned)(((16 * w4 + (lane >> 2)) * T.vp + (lane & 3) * 8) * 2);
    auto dmaK = [&](int t) {
        const unsigned kd = (unsigned)__builtin_amdgcn_readfirstlane((int)(lds0 + (t & 3) * SLOT + KOFF + w4 * 1024));
        const bf16_t* kb_ = T.K + (rowbase + (long)t * 64) * (long)T.kp;
        glds16s(kb_, koff, kd); glds16s(kb_ + 32, koff, kd + 4096); glds16s(kb_ + 64, koff, kd + 8192);
    };
    auto dmaV = [&](int t) {
        const unsigned vd = (unsigned)__builtin_amdgcn_readfirstlane((int)(lds0 + (t & 3) * SLOT + VOFF + w4 * 1024));
        const bf16_t* vb_ = T.V + (rowbase + (long)t * 64) * (long)T.vp;
        glds16s(vb_, voff, vd); glds16s(vb_ + 32, voff, vd + 4096);
    };
    if (g1) { dmaK(0); dmaK(1); } else { dmaV(0); dmaV(1); }
    bf16x8 qr[NKD];
    { const bf16_t* Qw = T.Q + (rowbase + qpos) * (long)T.qp;
#pragma unroll
      for (int d0 = 0; d0 < NKD; ++d0) qr[d0] = *(const bf16x8*)(Qw + d0 * 16 + hi * 8); }
    float l_reg = 0.f; f32x16 o[2]; o[0] = f32x16{}; o[1] = f32x16{};
    unsigned nx_ = 0u;
    const LAS char* vp0 = lds + VOFF + ((lane >> 4) & 1) * 32 + (lane & 3) * 8 + (4 * hi + ((lane & 15) >> 2)) * 64;
    const LAS char* kp0 = lds + KOFF + hi * 1024 + r32 * 16;
#pragma unroll
    for (int d0 = 0; d0 < NKD; ++d0) asm volatile("" : "+v"(qr[d0]));
    f32x16 p0 = f32x16{}, p1 = f32x16{}; u32x4 pw[4]; bool pend = false;
    s16x4 vlo[4], vhh[4];
#pragma unroll
    for (int i = 0; i < 4; ++i) pw[i] = (u32x4){0u, 0u, 0u, 0u};
#pragma unroll
    for (int i = 0; i < 4; ++i) { vlo[i] = s16x4{}; vhh[i] = s16x4{}; }
    auto tile_act = [&](int t) -> bool { const int jb = t - (NT - 4); return (jb < 0) || (2 * jb <= wid); };
    auto pre = [&](int t, bool rk, bool rv) {
        if (rv) { const LAS char* vb = vp0 + ((t - 1) & 3) * SLOT;
#pragma unroll
            for (int i = 0; i < 4; ++i) { vlo[i] = vtr(vb + i * 1024); vhh[i] = vtr(vb + i * 1024 + 512); } }
        (void)rk;
    };
    auto pv = [&](int tv) {
        const LAS char* vb = vp0 + (tv & 3) * SLOT + 4096; s16x4 wlo[4], whh[4];
#pragma unroll
        for (int i = 0; i < 4; ++i) { wlo[i] = vtr(vb + i * 1024); whh[i] = vtr(vb + i * 1024 + 512); }
        SBAR();
#pragma unroll
        for (int ks = 0; ks < 4; ++ks) { const bf16x8 vf = (bf16x8){vlo[ks][0], vlo[ks][1], vlo[ks][2], vlo[ks][3], vhh[ks][0], vhh[ks][1], vhh[ks][2], vhh[ks][3]};
            o[0] = __builtin_amdgcn_mfma_f32_32x32x16_bf16(vf, __builtin_bit_cast(bf16x8, pw[ks]), o[0], 0, 0, 0); }
#pragma unroll
        for (int ks = 0; ks < 4; ++ks) { const bf16x8 vf = (bf16x8){wlo[ks][0], wlo[ks][1], wlo[ks][2], wlo[ks][3], whh[ks][0], whh[ks][1], whh[ks][2], whh[ks][3]};
            o[1] = __builtin_amdgcn_mfma_f32_32x32x16_bf16(vf, __builtin_bit_cast(bf16x8, pw[ks]), o[1], 0, 0, 0); }
    };
    auto qk = [&](const bf16x8 (&kf)[2 * NKD]) {
        p0 = f32x16{}; p1 = f32x16{};
#pragma unroll
        for (int d0 = 0; d0 < NKD; ++d0) {
            p0 = __builtin_amdgcn_mfma_f32_32x32x16_bf16(kf[2 * d0], qr[d0], p0, 0, 0, 0);
            p1 = __builtin_amdgcn_mfma_f32_32x32x16_bf16(kf[2 * d0 + 1], qr[d0], p1, 0, 0, 0); }
    };
    auto h1 = [&](int t, bool full) {
        const bool aq = full || tile_act(t);
        if (aq) { const LAS char* kb = kp0 + (t & 3) * SLOT; bf16x8 kf[2 * NKD];
#pragma unroll
            for (int d0 = 0; d0 < NKD; ++d0) { kf[2 * d0] = *(const LAS bf16x8*)(kb + d0 * 2048); kf[2 * d0 + 1] = *(const LAS bf16x8*)(kb + d0 * 2048 + 512); }
            if (full || pend) { pv(t - 1); qk(kf); }
            else {
                asm volatile("" : "+v"(kf[0]), "+v"(kf[1]), "+v"(kf[2]), "+v"(kf[3]), "+v"(kf[4]), "+v"(kf[5]));
                p0 = f32x16{}; p1 = f32x16{};
#pragma unroll
                for (int d0 = 0; d0 < NKD / 2; ++d0) { p0 = __builtin_amdgcn_mfma_f32_32x32x16_bf16(kf[2 * d0], qr[d0], p0, 0, 0, 0); p1 = __builtin_amdgcn_mfma_f32_32x32x16_bf16(kf[2 * d0 + 1], qr[d0], p1, 0, 0, 0); }
                asm volatile("" : "+v"(kf[6]), "+v"(kf[7]), "+v"(kf[8]), "+v"(kf[9]), "+v"(kf[10]), "+v"(kf[11]));
#pragma unroll
                for (int d0 = NKD / 2; d0 < NKD; ++d0) { p0 = __builtin_amdgcn_mfma_f32_32x32x16_bf16(kf[2 * d0], qr[d0], p0, 0, 0, 0); p1 = __builtin_amdgcn_mfma_f32_32x32x16_bf16(kf[2 * d0 + 1], qr[d0], p1, 0, 0, 0); }
            }
        } else if (pend) pv(t - 1);
        pend = false; };
    auto h2 = [&](int t, bool full) {
        if (!full && !tile_act(t)) return;
        const int jb = full ? -1 : t - (NT - 4);
        if (jb >= 0) { const int lb = launder(tidx()) & 63, qposb = q0 + wid * 32 + (lb & 31); const int kbase = 64 * t + 4 * (lb >> 5);
#pragma unroll
            for (int r = 0; r < 16; ++r) { const int kv = kbase + (r & 3) + 8 * (r >> 2); if (kv > qposb) p0[r] = -INFINITY; if (kv + 32 > qposb) p1[r] = -INFINITY; } }
        f32x2 s2 = {0.f, 0.f};
#pragma unroll
        for (int i = 0; i < 8; ++i) { p0[2 * i] = __builtin_amdgcn_exp2f(p0[2 * i]); p0[2 * i + 1] = __builtin_amdgcn_exp2f(p0[2 * i + 1]); p1[2 * i] = __builtin_amdgcn_exp2f(p1[2 * i]); p1[2 * i + 1] = __builtin_amdgcn_exp2f(p1[2 * i + 1]);
            s2 += (f32x2){p0[2 * i], p0[2 * i + 1]}; s2 += (f32x2){p1[2 * i], p1[2 * i + 1]}; }
        l_reg += s2.x + s2.y;
#pragma unroll
        for (int i = 0; i < 4; ++i) { pw[0][i] = cvtpk_s(p0[2 * i], p0[2 * i + 1]); pw[1][i] = cvtpk_s(p0[8 + 2 * i], p0[8 + 2 * i + 1]); pw[2][i] = cvtpk_s(p1[2 * i], p1[2 * i + 1]); pw[3][i] = cvtpk_s(p1[8 + 2 * i], p1[8 + 2 * i + 1]); }
        pend = true;
    };
    auto fin = [&]() {
        u32x4 gpf[4];
        { const int le = launder(tidx()) & 63; const long or0 = rowbase + q0 + wid * 32;
#pragma unroll
          for (int i = 0; i < 4; ++i) gpf[i] = *(const u32x4*)(T.G + (or0 + i * 8 + (le >> 3)) * (long)T.gp + (le & 7) * 8); }
        SBAR();
        if (pend) pv(NT - 1);
        pend = false;
        if (launder(tidx()) == 0) *qslot = nx_;
        { auto rr = __builtin_amdgcn_permlane32_swap(__float_as_uint(l_reg), __float_as_uint(l_reg), false, false); l_reg = __uint_as_float(rr[0]) + __uint_as_float(rr[1]); }
        const int lf = launder(tidx()) & 63, r32f = lf & 31, hif = lf >> 5;
        const float rl = __builtin_amdgcn_rcpf(l_reg);
        LAS char* stg = lds + L_OST + wid * OST_W;
#pragma unroll
        for (int dh = 0; dh < 2; ++dh)
#pragma unroll
            for (int g = 0; g < 4; ++g) { u32x2 w; w.x = pk2(o[dh][4 * g] * rl, o[dh][4 * g + 1] * rl); w.y = pk2(o[dh][4 * g + 2] * rl, o[dh][4 * g + 3] * rl);
                *(LAS u32x2*)(stg + r32f * 144 + (32 * dh + 8 * g + 4 * hif) * 2) = w; }
        LDS_WAIT();
        const long orow0 = rowbase + q0 + wid * 32; const int lane_e = launder(tidx()) & 63;
        u32x4 ovs[4];
#pragma unroll
        for (int i = 0; i < 4; ++i) ovs[i] = *(const LAS u32x4*)(stg + (i * 8 + (lane_e >> 3)) * 144 + (lane_e & 7) * 16);
        SBAR();
#pragma unroll
        for (int i = 0; i < 4; ++i) { const int row = i * 8 + (lane_e >> 3), ch = lane_e & 7;
            const u32x4 ov = ovs[i];
            const u32x4 gv = gpf[i];
            u32x4 res;
#pragma unroll
            for (int e = 0; e < 4; ++e) { const float g0 = bflo(gv[e]), g1_ = bfhi(gv[e]);
                const float s0 = g0 * __builtin_amdgcn_rcpf(1.0f + __expf(-g0)), s1 = g1_ * __builtin_amdgcn_rcpf(1.0f + __expf(-g1_));
                res[e] = pk2(bflo(ov[e]) * s0, bfhi(ov[e]) * s1); }
            store16_wt(T.O + (orow0 + row) * (long)T.op + ch * 8, res); }
    };
#define ATT_BE() asm volatile("s_waitcnt lgkmcnt(0)\n\ts_barrier" ::: "memory")
#define ATT_BO5() asm volatile("s_waitcnt vmcnt(3) lgkmcnt(0)\n\ts_barrier" ::: "memory")
#define ATT_BO0() asm volatile("s_waitcnt vmcnt(0) lgkmcnt(0)\n\ts_barrier" ::: "memory")
    asm volatile("s_waitcnt vmcnt(0) lgkmcnt(0)\n\ts_barrier" ::: "memory");
    if (pslot >= 0 && launder(tidx()) == 0) { (void)__hip_atomic_fetch_add(pcb + pslot * 16, 1u, __ATOMIC_RELAXED, __HIP_MEMORY_SCOPE_AGENT); (void)__hip_atomic_fetch_add(pcb + fslot * 16, 1u, __ATOMIC_RELAXED, __HIP_MEMORY_SCOPE_AGENT); }
    if (!g1) {
        pre(0, true, false);
        ATT_BE(); h1(0, false); ATT_BO0(); dmaV(2); pre(1, tile_act(1), tile_act(0)); h2(0, NT > 4);
        int t = 1;
        for (; t < NT - 4; ++t) { ATT_BE(); h1(t, true); ATT_BO0(); dmaV(t + 2); pre(t + 1, true, true); h2(t, true); }
        const int tf = t;
        for (; t < NT; ++t) { ATT_BE(); h1(t, false); ATT_BO0(); if (t == tf && launder(tidx()) == 0) nx_ = __hip_atomic_fetch_add(qnext, 1u, __ATOMIC_RELAXED, __HIP_MEMORY_SCOPE_AGENT); if (t + 2 < NT) dmaV(t + 2); pre(t + 1, (t + 1 < NT) && tile_act(t + 1), tile_act(t)); h2(t, false); }
        ATT_BE(); fin(); ATT_BO0();
    } else {
        ATT_BE(); dmaK(2); pre(0, true, false); ATT_BO5(); h1(0, false);
        int t = 1;
        for (; t < NT - 4; ++t) { ATT_BE(); dmaK(t + 2); pre(t, true, true); h2(t - 1, true); ATT_BO5(); h1(t, true); }
        for (; t < NT; ++t) { ATT_BE(); const bool more = t + 2 < NT; if (more) dmaK(t + 2); pre(t, tile_act(t), tile_act(t - 1)); h2(t - 1, t - 1 < NT - 4); if (more) ATT_BO5(); else ATT_BO0(); h1(t, false); }
        ATT_BE(); pre(NT, false, tile_act(NT - 1)); h2(NT - 1, false); ATT_BO0(); fin();
    }
#undef ATT_BE
#undef ATT_BO5
#undef ATT_BO0
    asm volatile("s_waitcnt lgkmcnt(0)\n\ts_barrier" ::: "memory");
}
}


namespace moba {
constexpr int L_PL = 0, L_LPL = 98304, L_BIAS = L_LPL + 3072, L_LIST = L_BIAS + 32768, LIST_N = 1792, L_TILES = L_LIST + LIST_N * 2, L_CNT = L_TILES + 256, L_START = L_CNT + 512, L_MISC = L_START + 128, L_TRASH = L_MISC + 64, L_NEG = L_TRASH + 128, L_MASK = L_NEG + 16, L_END = L_MASK + 1024, NEG_IDX = (L_NEG - L_BIAS) / 4;
using att::crow; using att::cvtpk_s; using att::bucket;
struct Tens { const bf16_t* Q; int qp; const bf16_t* G; int gp; bf16_t* O; int op; const float* kpart; const float* bias; const bf16_t* KF; const bf16_t* VF; float Bshift; };

template <bool OWN>
__device__ __forceinline__ void tile(const Tens& T, const LAS float* biasL, int bh, int j, int nst, int qpos, bool valid, long rowbase, int lane, int hi, f32x16 (&o)[2], float& lsum,
                                     bool pre, const bf16x8 (&qi)[4], const bf16x8 (&ki)[8], const bf16x8 (&vi)[8]) {
    bf16x8 qr[4];
    if (pre) {
#pragma unroll
        for (int d0 = 0; d0 < 4; ++d0) qr[d0] = qi[d0];
    } else { const bf16_t* Qw = T.Q + (rowbase + qpos) * (long)T.qp;
#pragma unroll
      for (int d0 = 0; d0 < 4; ++d0) qr[d0] = *(const bf16x8*)(Qw + d0 * 16 + hi * 8); }
    o[0] = f32x16{}; o[1] = f32x16{}; lsum = 0.f;
    const bf16_t* kfp = T.KF + (((size_t)bh * 256 + (size_t)j * 8) * 4 * 64 + lane) * 8;
    const bf16_t* vfp = T.VF + (((size_t)bh * 512 + (size_t)j * 16) * 2 * 64 + lane) * 8;
    bf16x8 kf[8], vf[8];
    if (pre) {
#pragma unroll
        for (int i = 0; i < 8; ++i) { kf[i] = ki[i]; vf[i] = vi[i]; }
    } else {
#pragma unroll
        for (int d0 = 0; d0 < 4; ++d0) { kf[2 * d0] = *(const bf16x8*)(kfp + (0 * 4 + d0) * 512); kf[2 * d0 + 1] = *(const bf16x8*)(kfp + (1 * 4 + d0) * 512); }
#pragma unroll
        for (int k = 0; k < 4; ++k) { vf[k] = *(const bf16x8*)(vfp + ((size_t)k * 2 + 0) * 512); vf[4 + k] = *(const bf16x8*)(vfp + ((size_t)k * 2 + 1) * 512); }
    }
    f32x16 p0, p1; float cm; u32x4 pw[4];
    auto qk_bias = [&](int st) {
        const int sn = (st + 1 < nst) ? st + 1 : st;
        p0 = f32x16{}; p1 = f32x16{};
#pragma unroll
        for (int d0 = 0; d0 < 4; ++d0) {
            p0 = __builtin_amdgcn_mfma_f32_32x32x16_bf16(kf[2 * d0], qr[d0], p0, 0, 0, 0);
            p1 = __builtin_amdgcn_mfma_f32_32x32x16_bf16(kf[2 * d0 + 1], qr[d0], p1, 0, 0, 0); }
#pragma unroll
        for (int d0 = 0; d0 < 4; ++d0) { kf[2 * d0] = *(const bf16x8*)(kfp + ((size_t)(2 * sn) * 4 + d0) * 512); kf[2 * d0 + 1] = *(const bf16x8*)(kfp + ((size_t)(2 * sn + 1) * 4 + d0) * 512); }
        const int keybase = 256 * j + 64 * st, kb4 = keybase + 4 * hi;
        if (!OWN || st + 1 < nst) {
            const int dmin = qpos - keybase - 63, dmax = qpos - keybase;
            const bool uni = bucket(dmin) == bucket(dmax);
            float c = 0.f;
            if (__all(uni)) c = biasL[dmin];
            else {
                const LAS float* bp = biasL + (qpos - kb4 - 59);
#pragma unroll
                for (int r = 0; r < 16; ++r) { const int cr = (r & 3) + 8 * (r >> 2); p0[r] += bp[59 - cr]; p1[r] += bp[59 - cr - 32]; }
            }
            cm = valid ? (c - T.Bshift) : -INFINITY;
        } else {
#pragma unroll
            for (int r = 0; r < 16; ++r) { const int kv = kb4 + (r & 3) + 8 * (r >> 2); const int d0_ = qpos - kv, d1_ = d0_ - 32;
                p0[r] += biasL[(d0_ >= 0) ? d0_ : NEG_IDX]; p1[r] += biasL[(d1_ >= 0) ? d1_ : NEG_IDX]; }
            cm = -T.Bshift;
        }
    };
    auto pack = [&]() {
#pragma unroll
        for (int i = 0; i < 4; ++i) { pw[0][i] = cvtpk_s(p0[2 * i], p0[2 * i + 1]); pw[1][i] = cvtpk_s(p0[8 + 2 * i], p0[8 + 2 * i + 1]); pw[2][i] = cvtpk_s(p1[2 * i], p1[2 * i + 1]); pw[3][i] = cvtpk_s(p1[8 + 2 * i], p1[8 + 2 * i + 1]); }
    };
    qk_bias(0);
    { float sacc = 0.f;
#pragma unroll
      for (int r = 0; r < 16; ++r) { p0[r] = __builtin_amdgcn_exp2f(p0[r] + cm); p1[r] = __builtin_amdgcn_exp2f(p1[r] + cm); sacc += p0[r] + p1[r]; }
      lsum += sacc; }
    pack();
#pragma unroll 1
    for (int st = 1; st < nst; ++st) {
        qk_bias(st);
        float sacc = 0.f;
#pragma unroll
        for (int g = 0; g < 8; ++g) {
            o[g >> 2] = __builtin_amdgcn_mfma_f32_32x32x16_bf16(vf[g], __builtin_bit_cast(bf16x8, pw[g & 3]), o[g >> 2], 0, 0, 0);
#pragma unroll
            for (int e = 0; e < 2; ++e) { const int r = 2 * g + e; p0[r] = __builtin_amdgcn_exp2f(p0[r] + cm); p1[r] = __builtin_amdgcn_exp2f(p1[r] + cm); sacc += p0[r] + p1[r]; }
        }
        lsum += sacc;
#pragma unroll
        for (int k = 0; k < 4; ++k) { vf[k] = *(const bf16x8*)(vfp + ((size_t)(4 * st + k) * 2 + 0) * 512); vf[4 + k] = *(const bf16x8*)(vfp + ((size_t)(4 * st + k) * 2 + 1) * 512); }
        pack();
    }
#pragma unroll
    for (int g = 0; g < 8; ++g) o[g >> 2] = __builtin_amdgcn_mfma_f32_32x32x16_bf16(vf[g], __builtin_bit_cast(bf16x8, pw[g & 3]), o[g >> 2], 0, 0, 0);
}

__device__ __forceinline__ bool pair_stream(const Tens& T, const LAS float* biasL, int bh, int q0, long rowbase, int lane, int r32, int hi, unsigned ntiles,
                                            LAS unsigned* misc, const LAS unsigned* tiles, const LAS unsigned short* list, LAS bf16_t* pl, LAS float* lpl,
                                            int own_j, int own_qpos, bf16x8 (&qo)[4], bf16x8 (&ko)[8], bf16x8 (&vo)[8]) {
    auto fetch = [&]() -> unsigned { unsigned ti = 0u; if (lane == 0) ti = __hip_atomic_fetch_add(misc, 1u, __ATOMIC_RELAXED, __HIP_MEMORY_SCOPE_WORKGROUP); return (unsigned)__builtin_amdgcn_readfirstlane((int)ti); };
    unsigned ti = fetch();
    if (ti >= ntiles) return false;
    unsigned te = tiles[ti]; int off = (int)(te & 0xffffu), j = (int)(te >> 16);
    unsigned v16 = list[off + r32]; bool valid = v16 != 0xFFFFu; int qpos = q0 + (valid ? (int)(v16 & 255u) : 0);
    bf16x8 qr[4], kf[8], vf[8];
    { const bf16_t* Qw = T.Q + (rowbase + qpos) * (long)T.qp;
#pragma unroll
      for (int d0 = 0; d0 < 4; ++d0) qr[d0] = *(const bf16x8*)(Qw + d0 * 16 + hi * 8); }
    const bf16_t* kfp = T.KF + (((size_t)bh * 256 + (size_t)j * 8) * 4 * 64 + lane) * 8;
    const bf16_t* vfp = T.VF + (((size_t)bh * 512 + (size_t)j * 16) * 2 * 64 + lane) * 8;
#pragma unroll
    for (int d0 = 0; d0 < 4; ++d0) { kf[2 * d0] = *(const bf16x8*)(kfp + (0 * 4 + d0) * 512); kf[2 * d0 + 1] = *(const bf16x8*)(kfp + (1 * 4 + d0) * 512); }
#pragma unroll
    for (int k = 0; k < 4; ++k) { vf[k] = *(const bf16x8*)(vfp + ((size_t)k * 2 + 0) * 512); vf[4 + k] = *(const bf16x8*)(vfp + ((size_t)k * 2 + 1) * 512); }
#pragma unroll 1
    for (;;) {
        unsigned tn = ti; bool hn = false; int offn = off, jn = j; unsigned v16n = v16; bool validn = valid; int qposn = qpos; const bf16_t* kfn = kfp; unsigned traw = 0u;
        f32x16 o[2]; o[0] = f32x16{}; o[1] = f32x16{}; float lsum = 0.f;
        f32x16 p0, p1; u32x4 pw[4];
        auto qk_bias = [&](int st) {
            const int keybase = 256 * j + 64 * st, kb4 = keybase + 4 * hi;
            const int dmin = qpos - keybase - 63, dmax = qpos - keybase;
            const bool allu = __all(bucket(dmin) == bucket(dmax));
            const float cinit = valid ? ((allu ? biasL[dmin] : 0.f) - T.Bshift) : -INFINITY;
            f32x16 ci;
#pragma unroll
            for (int r = 0; r < 16; ++r) ci[r] = cinit;
            p0 = __builtin_amdgcn_mfma_f32_32x32x16_bf16(kf[0], qr[0], ci, 0, 0, 0);
            p1 = __builtin_amdgcn_mfma_f32_32x32x16_bf16(kf[1], qr[0], ci, 0, 0, 0);
#pragma unroll
            for (int d0 = 1; d0 < 4; ++d0) {
                p0 = __builtin_amdgcn_mfma_f32_32x32x16_bf16(kf[2 * d0], qr[d0], p0, 0, 0, 0);
                p1 = __builtin_amdgcn_mfma_f32_32x32x16_bf16(kf[2 * d0 + 1], qr[d0], p1, 0, 0, 0); }
            const bf16_t* ksrc = (st < 3) ? kfp + (size_t)(2 * (st + 1)) * 4 * 512 : kfn;
#pragma unroll
            for (int d0 = 0; d0 < 4; ++d0) { kf[2 * d0] = *(const bf16x8*)(ksrc + (0 * 4 + d0) * 512); kf[2 * d0 + 1] = *(const bf16x8*)(ksrc + (1 * 4 + d0) * 512); }
            if (st == 3) { const bf16_t* Qw = T.Q + (rowbase + qposn) * (long)T.qp;
#pragma unroll
                for (int d0 = 0; d0 < 4; ++d0) qr[d0] = *(const bf16x8*)(Qw + d0 * 16 + hi * 8); }
            if (!allu) {
                const LAS float* bp = biasL + (qpos - kb4 - 59);
#pragma unroll
                for (int hh = 0; hh < 2; ++hh) {
                    float tb0[8], tb1[8];
#pragma unroll
                    for (int r = 0; r < 8; ++r) { const int rr = 8 * hh + r, cr = (rr & 3) + 8 * (rr >> 2); tb0[r] = bp[59 - cr]; tb1[r] = bp[59 - cr - 32]; }
                    asm volatile("" : "+v"(tb0[0]), "+v"(tb0[1]), "+v"(tb0[2]), "+v"(tb0[3]), "+v"(tb0[4]), "+v"(tb0[5]), "+v"(tb0[6]), "+v"(tb0[7]),
                                      "+v"(tb1[0]), "+v"(tb1[1]), "+v"(tb1[2]), "+v"(tb1[3]), "+v"(tb1[4]), "+v"(tb1[5]), "+v"(tb1[6]), "+v"(tb1[7]));
#pragma unroll
                    for (int r = 0; r < 8; ++r) { p0[8 * hh + r] += tb0[r]; p1[8 * hh + r] += tb1[r]; }
                    __builtin_amdgcn_sched_barrier(0); }
            }
        };
        auto pack = [&]() {
#pragma unroll
            for (int i = 0; i < 4; ++i) { pw[0][i] = cvtpk_s(p0[2 * i], p0[2 * i + 1]); pw[1][i] = cvtpk_s(p0[8 + 2 * i], p0[8 + 2 * i + 1]); pw[2][i] = cvtpk_s(p1[2 * i], p1[2 * i + 1]); pw[3][i] = cvtpk_s(p1[8 + 2 * i], p1[8 + 2 * i + 1]); }
        };
        qk_bias(0);
        { float sacc;
#pragma unroll
          for (int r = 0; r < 16; ++r) { p0[r] = __builtin_amdgcn_exp2f(p0[r]); p1[r] = __builtin_amdgcn_exp2f(p1[r]); }
          f32x2 s2 = {0.f, 0.f};
#pragma unroll
          for (int i = 0; i < 8; ++i) { s2 += (f32x2){p0[2 * i], p0[2 * i + 1]}; s2 += (f32x2){p1[2 * i], p1[2 * i + 1]}; }
          sacc = s2.x + s2.y; lsum += sacc; }
        pack();
#pragma unroll 1
        for (int st = 1; st < 4; ++st) {
            if (st == 1) { traw = 0u; if (lane == 0) traw = __hip_atomic_fetch_add(misc, 1u, __ATOMIC_RELAXED, __HIP_MEMORY_SCOPE_WORKGROUP); }
            if (st == 2) { tn = (unsigned)__builtin_amdgcn_readfirstlane((int)traw); hn = tn < ntiles; traw = tiles[hn ? tn : ti]; }
            if (st == 3) {
                if (hn) { offn = (int)(traw & 0xffffu); jn = (int)(traw >> 16); v16n = list[offn + r32]; validn = v16n != 0xFFFFu; qposn = q0 + (validn ? (int)(v16n & 255u) : 0); }
                else { jn = own_j; qposn = own_qpos; }
                kfn = T.KF + (((size_t)bh * 256 + (size_t)jn * 8) * 4 * 64 + lane) * 8; }
            qk_bias(st);
            f32x2 s2 = {0.f, 0.f};
#pragma unroll
            for (int g = 0; g < 8; ++g) {
                o[g >> 2] = __builtin_amdgcn_mfma_f32_32x32x16_bf16(vf[g], __builtin_bit_cast(bf16x8, pw[g & 3]), o[g >> 2], 0, 0, 0);
                p0[2 * g] = __builtin_amdgcn_exp2f(p0[2 * g]); p0[2 * g + 1] = __builtin_amdgcn_exp2f(p0[2 * g + 1]); p1[2 * g] = __builtin_amdgcn_exp2f(p1[2 * g]); p1[2 * g + 1] = __builtin_amdgcn_exp2f(p1[2 * g + 1]);
                s2 += (f32x2){p0[2 * g], p0[2 * g + 1]}; s2 += (f32x2){p1[2 * g], p1[2 * g + 1]};
            }
            lsum += s2.x + s2.y;
#pragma unroll
            for (int k = 0; k < 4; ++k) { vf[k] = *(const bf16x8*)(vfp + ((size_t)(4 * st + k) * 2 + 0) * 512); vf[4 + k] = *(const bf16x8*)(vfp + ((size_t)(4 * st + k) * 2 + 1) * 512); }
            pack();
        }
#pragma unroll
        for (int g = 0; g < 8; ++g) o[g >> 2] = __builtin_amdgcn_mfma_f32_32x32x16_bf16(vf[g], __builtin_bit_cast(bf16x8, pw[g & 3]), o[g >> 2], 0, 0, 0);
        const bf16_t* vfn = T.VF + (((size_t)bh * 512 + (size_t)jn * 16) * 2 * 64 + lane) * 8;
#pragma unroll
        for (int k = 0; k < 4; ++k) { vf[k] = *(const bf16x8*)(vfn + ((size_t)k * 2 + 0) * 512); vf[4 + k] = *(const bf16x8*)(vfn + ((size_t)k * 2 + 1) * 512); }
        { auto rr = __builtin_amdgcn_permlane32_swap(__float_as_uint(lsum), __float_as_uint(lsum), false, false); lsum = __uint_as_float(rr[0]) + __uint_as_float(rr[1]); }
        if (hi == 0 && valid) lpl[((v16 >> 8) & 3u) * 256 + (int)(v16 & 255u)] = lsum;
        { const unsigned bo = valid ? ((v16 & 0x3ffu) << 7) : (unsigned)L_TRASH, swz = valid ? (v16 & 15u) : 0u;
          LAS char* dstb = (LAS char*)pl + bo;
#pragma unroll
          for (int dh = 0; dh < 2; ++dh)
#pragma unroll
              for (int g = 0; g < 4; ++g) { u32x2 w; w.x = pk2(o[dh][4 * g], o[dh][4 * g + 1]); w.y = pk2(o[dh][4 * g + 2], o[dh][4 * g + 3]);
                  *(LAS u32x2*)(dstb + ((((unsigned)(8 * dh + 2 * g + hi)) ^ swz) << 3)) = w; } }
        if (!hn) break;
        ti = tn; off = offn; j = jn; v16 = v16n; valid = validn; qpos = qposn; kfp = kfn; vfp = vfn;
    }
#pragma unroll
    for (int d0 = 0; d0 < 4; ++d0) qo[d0] = qr[d0];
#pragma unroll
    for (int i = 0; i < 8; ++i) { ko[i] = kf[i]; vo[i] = vf[i]; }
    return true;
}

__device__ __forceinline__ void unit(const Tens& T, int b, int h, int qb, LAS char* lds, unsigned* qnext, volatile LAS unsigned* qslot, unsigned* pcb, int pslot, int fslot) {
    const int tid = launder(tidx()), lane = tid & 63, r32 = lane & 31, hi = lane >> 5; const int wid = __builtin_amdgcn_readfirstlane(tid >> 6);
    const long rowbase = (long)b * SEQ; const int q0 = qb * 256, bh = b * 8 + h;
    LAS bf16_t* pl = (LAS bf16_t*)(lds + L_PL); LAS float* lpl = (LAS float*)(lds + L_LPL);
    const LAS float* biasL = (const LAS float*)(lds + L_BIAS);
    LAS unsigned short* list = (LAS unsigned short*)(lds + L_LIST);
    LAS unsigned* tiles = (LAS unsigned*)(lds + L_TILES); LAS unsigned* cntw = (LAS unsigned*)(lds + L_CNT); LAS unsigned* startv = (LAS unsigned*)(lds + L_START);
    LAS unsigned* misc = (LAS unsigned*)(lds + L_MISC);
    const int npick = qb < 3 ? qb : 3;
    f32x4 bt[4];
#pragma unroll
    for (int i = 0; i < 4; ++i) bt[i] = *(const f32x4*)(T.bias + (tid + 512 * i) * 4);
    for (int i = tid; i < LIST_N / 2; i += 512) ((LAS unsigned*)(lds + L_LIST))[i] = 0xFFFFFFFFu;
    if (tid == 0) { misc[0] = 0u; *(LAS float*)(lds + L_NEG) = -INFINITY; }
    unsigned selm = 0u;
    if (qb > 0) {
        constexpr int KMS = 68, PSTR = 260;
        LAS float* kmL = (LAS float*)(lds + L_PL);
        LAS float* part = (LAS float*)(lds + L_PL + 32 * KMS * 4);
        bf16x8 qf[4];
        { const bf16_t* qp_ = T.Q + (rowbase + q0 + 32 * wid + r32) * (long)T.qp + 8 * hi;
#pragma unroll
          for (int d0 = 0; d0 < 4; ++d0) qf[d0] = *(const bf16x8*)(qp_ + 16 * d0); }
        float ks_[4][4];
#pragma unroll
        for (int k = 0; k < 4; ++k) { const int idx = tid + 512 * k, idc = idx < qb * 64 ? idx : 0, j = idc >> 6, d = idc & 63;
            const float* p = T.kpart + ((size_t)(b * 32 + j) * 4) * 512 + h * 64 + d;
#pragma unroll
            for (int c = 0; c < 4; ++c) ks_[k][c] = p[512 * c]; }
        SBAR();
#pragma unroll
        for (int k = 0; k < 4; ++k) { const int idx = tid + 512 * k; if (idx < qb * 64) kmL[(idx >> 6) * KMS + (idx & 63)] = (((ks_[k][0] + ks_[k][1]) + ks_[k][2]) + ks_[k][3]) * (1.0f / 256.0f); }
        __syncthreads();
        { f32x16 sc = f32x16{};
#pragma unroll
          for (int d0 = 0; d0 < 4; ++d0) { const LAS float* km = kmL + r32 * KMS + 16 * d0 + 8 * hi;
              const f32x4 x0 = *(const LAS f32x4*)km, x1 = *(const LAS f32x4*)(km + 4);
              u32x4 hh, ll;
              hh.x = pk2(x0.x, x0.y); hh.y = pk2(x0.z, x0.w); hh.z = pk2(x1.x, x1.y); hh.w = pk2(x1.z, x1.w);
              ll.x = pk2(x0.x - bflo(hh.x), x0.y - bfhi(hh.x)); ll.y = pk2(x0.z - bflo(hh.y), x0.w - bfhi(hh.y)); ll.z = pk2(x1.x - bflo(hh.z), x1.y - bfhi(hh.z)); ll.w = pk2(x1.z - bflo(hh.w), x1.w - bfhi(hh.w));
              sc = __builtin_amdgcn_mfma_f32_32x32x16_bf16(qf[d0], __builtin_bit_cast(bf16x8, hh), sc, 0, 0, 0);
              sc = __builtin_amdgcn_mfma_f32_32x32x16_bf16(qf[d0], __builtin_bit_cast(bf16x8, ll), sc, 0, 0, 0); }
          const bool past = r32 < qb;
#pragma unroll
          for (int g = 0; g < 4; ++g) { f32x4 v; v.x = past ? sc[4 * g] : -INFINITY; v.y = past ? sc[4 * g + 1] : -INFINITY; v.z = past ? sc[4 * g + 2] : -INFINITY; v.w = past ? sc[4 * g + 3] : -INFINITY;
              *(LAS f32x4*)(part + r32 * PSTR + 32 * wid + 8 * g + 4 * hi) = v; } }
        __syncthreads();
        if (tid < 256) {
            float v0 = -INFINITY, v1 = -INFINITY, v2 = -INFINITY; int i0 = 0, i1 = 0, i2 = 0;
            for (int j4 = 0; j4 < qb; j4 += 4) {
                float d4[4];
#pragma unroll
                for (int u = 0; u < 4; ++u) d4[u] = part[(j4 + u) * PSTR + tid];
#pragma unroll
                for (int u = 0; u < 4; ++u) { const float d = d4[u]; const int j = j4 + u;
                    const bool c0 = d > v0, c1 = d > v1, c2 = d > v2;
                    i2 = c1 ? i1 : (c2 ? j : i2); i1 = c0 ? i0 : (c1 ? j : i1); i0 = c0 ? j : i0;
                    v2 = __builtin_amdgcn_fmed3f(v1, v2, d); v1 = __builtin_amdgcn_fmed3f(v0, v1, d); v0 = fmaxf(v0, d); } }
            selm = 1u << i0; if (qb > 1) selm |= 1u << i1; if (qb > 2) selm |= 1u << i2;
        }
    }
    int pj0 = 0, pj1 = 0, pj2 = 0; unsigned pr0 = 0u, pr1 = 0u, pr2 = 0u;
    if (wid < 4) {
        unsigned mlo = 0u, mhi = 0u;
        for (int j = 0; j < qb; ++j) { const unsigned long long m = __ballot((selm >> j) & 1u);
            mlo = (lane == j) ? (unsigned)m : mlo; mhi = (lane == j) ? (unsigned)(m >> 32) : mhi; }
        LAS u32x2* mk = (LAS u32x2*)(lds + L_MASK) + wid * 32;
        if (lane < 32) { u32x2 mm; mm.x = mlo; mm.y = mhi; mk[lane] = mm; cntw[wid * 32 + lane] = (unsigned)__popc(mlo) + (unsigned)__popc(mhi); }
        const unsigned long long lt = (1ull << lane) - 1ull; const unsigned ltlo = (unsigned)lt, lthi = (unsigned)(lt >> 32);
        unsigned sm = selm;
        if (npick > 0) { pj0 = __builtin_ctz(sm); sm &= sm - 1u; const u32x2 m = mk[pj0]; pr0 = (unsigned)__popc(m.x & ltlo) + (unsigned)__popc(m.y & lthi); }
        if (npick > 1) { pj1 = __builtin_ctz(sm); sm &= sm - 1u; const u32x2 m = mk[pj1]; pr1 = (unsigned)__popc(m.x & ltlo) + (unsigned)__popc(m.y & lthi); }
        if (npick > 2) { pj2 = __builtin_ctz(sm); const u32x2 m = mk[pj2]; pr2 = (unsigned)__popc(m.x & ltlo) + (unsigned)__popc(m.y & lthi); }
    }
    asm volatile("s_waitcnt vmcnt(0)" ::: "memory");
    __syncthreads();
    if (pslot >= 0 && launder(tidx()) == 0) { (void)__hip_atomic_fetch_add(pcb + pslot * 16, 1u, __ATOMIC_RELAXED, __HIP_MEMORY_SCOPE_AGENT); (void)__hip_atomic_fetch_add(pcb + fslot * 16, 1u, __ATOMIC_RELAXED, __HIP_MEMORY_SCOPE_AGENT); }
    if (wid == 0) {
        const int j = lane & 31; unsigned c0 = 0u, c1 = 0u, c2 = 0u, c3 = 0u;
        if (j < qb) { c0 = cntw[j]; c1 = cntw[32 + j]; c2 = cntw[64 + j]; c3 = cntw[96 + j]; }
        const unsigned tl = (c0 + c1 + c2 + c3 + 31u) >> 5;
        unsigned x = tl;
        x += (unsigned)__builtin_amdgcn_update_dpp(0, (int)x, 0x111, 0xF, 0xF, true);
        x += (unsigned)__builtin_amdgcn_update_dpp(0, (int)x, 0x112, 0xF, 0xF, true);
        x += (unsigned)__builtin_amdgcn_update_dpp(0, (int)x, 0x114, 0xF, 0xF, true);
        x += (unsigned)__builtin_amdgcn_update_dpp(0, (int)x, 0x118, 0xF, 0xF, true);
        x += (unsigned)__builtin_amdgcn_update_dpp(0, (int)x, 0x142, 0xA, 0xF, false);
        const unsigned excl = x - tl, total = (unsigned)__builtin_amdgcn_readlane((int)x, 31);
        if (lane < 32) { const unsigned s0 = 32u * excl; cntw[j] = s0; cntw[32 + j] = s0 + c0; cntw[64 + j] = s0 + c0 + c1; cntw[96 + j] = s0 + c0 + c1 + c2;
            for (unsigned c = 0; c < tl; ++c) tiles[excl + c] = ((unsigned)j << 16) | (32u * (excl + c)); }
        if (lane == 0) misc[1] = total;
    }
    { LAS f32x4* bl = (LAS f32x4*)(lds + L_BIAS);
#pragma unroll
      for (int i = 0; i < 4; ++i) bl[tid + 512 * i] = bt[i]; }
    __syncthreads();
    if (wid < 4) {
        if (npick > 0) list[cntw[wid * 32 + pj0] + pr0] = (unsigned short)((unsigned)tid);
        if (npick > 1) list[cntw[wid * 32 + pj1] + pr1] = (unsigned short)((unsigned)tid | (1u << 8));
        if (npick > 2) list[cntw[wid * 32 + pj2] + pr2] = (unsigned short)((unsigned)tid | (2u << 8));
    }
    __syncthreads();
    const unsigned ntiles = misc[1];
    const int oi_ = (wid < 4) ? 7 - wid : wid - 4;
    bf16x8 qo[4], ko[8], vo[8];
#pragma unroll
    for (int i = 0; i < 8; ++i) { ko[i] = bf16x8{}; vo[i] = bf16x8{}; }
#pragma unroll
    for (int i = 0; i < 4; ++i) qo[i] = bf16x8{};
    const bool pre = pair_stream(T, biasL, bh, q0, rowbase, lane, r32, hi, ntiles, misc, tiles, list, pl, lpl, qb, q0 + 32 * oi_ + r32, qo, ko, vo);
    const int oi = (wid < 4) ? 7 - wid : wid - 4;
    const int lane2 = launder(tidx()) & 63, r32b = lane2 & 31, hib = lane2 >> 5;
    u32x4 gpf[4];
    { const int le = launder(tidx()) & 63; const long or0 = rowbase + q0 + oi * 32;
#pragma unroll
      for (int i = 0; i < 4; ++i) gpf[i] = *(const u32x4*)(T.G + (or0 + i * 8 + (le >> 3)) * (long)T.gp + (le & 7) * 8); }
    SBAR();
    if (launder(tidx()) == 256) *qslot = __hip_atomic_fetch_add(qnext, 1u, __ATOMIC_RELAXED, __HIP_MEMORY_SCOPE_AGENT);
    f32x16 oo[2]; float lown;
    tile<true>(T, biasL, bh, qb, (oi >> 1) + 1, q0 + 32 * oi + r32b, true, rowbase, lane2, hib, oo, lown, pre, qo, ko, vo);
    __syncthreads();
    {
        f32x16 (&o)[2] = oo; float lsum = lown;
        { auto rr = __builtin_amdgcn_permlane32_swap(__float_as_uint(lsum), __float_as_uint(lsum), false, false); lsum = __uint_as_float(rr[0]) + __uint_as_float(rr[1]); }
        for (int k = 0; k < npick; ++k) lsum += lpl[k * 256 + 32 * oi + r32b];
        const int rowo = 32 * oi + r32b; const unsigned swz = (unsigned)rowo & 15u;
        for (int k = 0; k < npick; ++k) {
            u32x2 t[8]; const LAS char* src = (const LAS char*)pl + ((k * 256 + rowo) << 7);
#pragma unroll
            for (int c = 0; c < 8; ++c) t[c] = *(const LAS u32x2*)(src + ((((unsigned)(8 * (c >> 2) + 2 * (c & 3) + hib)) ^ swz) << 3));
            SBAR();
#pragma unroll
            for (int c = 0; c < 8; ++c) { const int dh = c >> 2, g = c & 3; o[dh][4 * g] += bflo(t[c].x); o[dh][4 * g + 1] += bfhi(t[c].x); o[dh][4 * g + 2] += bflo(t[c].y); o[dh][4 * g + 3] += bfhi(t[c].y); }
        }
        const float rl = __builtin_amdgcn_rcpf(lsum);
        LAS char* stgb = (LAS char*)pl + ((32 * oi) << 7);
#pragma unroll
        for (int dh = 0; dh < 2; ++dh)
#pragma unroll
            for (int g = 0; g < 4; ++g) { u32x2 w; w.x = pk2(o[dh][4 * g] * rl, o[dh][4 * g + 1] * rl); w.y = pk2(o[dh][4 * g + 2] * rl, o[dh][4 * g + 3] * rl);
                *(LAS u32x2*)(stgb + (r32b << 7) + ((((unsigned)(8 * dh + 2 * g + hib)) ^ swz) << 3)) = w; }
        LDS_WAIT();
        const long orow0 = rowbase + q0 + oi * 32; const int lane_e = launder(tidx()) & 63;
        u32x4 ovs[4];
#pragma unroll
        for (int i = 0; i < 4; ++i) { const unsigned rowe = (unsigned)(i * 8 + (lane_e >> 3)), swr = rowe & 15u;
            const u32x4 v = *(const LAS u32x4*)(stgb + (rowe << 7) + ((((unsigned)(lane_e & 7)) ^ (swr >> 1)) << 4));
            ovs[i] = (swr & 1u) ? (u32x4){v.z, v.w, v.x, v.y} : v; }
        SBAR();
#pragma unroll
        for (int i = 0; i < 4; ++i) { const int row = i * 8 + (lane_e >> 3), ch = lane_e & 7;
            const u32x4 ov = ovs[i];
            const u32x4 gv = gpf[i];
            u32x4 res;
#pragma unroll
            for (int e = 0; e < 4; ++e) { const float g0 = bflo(gv[e]), g1_ = bfhi(gv[e]);
                const float s0 = g0 * __builtin_amdgcn_rcpf(1.0f + __expf(-g0)), s1 = g1_ * __builtin_amdgcn_rcpf(1.0f + __expf(-g1_));
                res[e] = pk2(bflo(ov[e]) * s0, bfhi(ov[e]) * s1); }
            store16_wt(T.O + (orow0 + row) * (long)T.op + ch * 8, res); }
    }
    __syncthreads();
}
}

#define XB_TMO      128
#define XB_XCNT(j)  (256  + 64 * (j))
#define XB_XSUB(j)  (1280 + 64 * (j))
#define XB_XGEN(j)  (2304 + 64 * (j))
#define XB_TOP      3328
#define XB_TOPGEN   3392
#define XCD_BAR_WORDS 3456
#define XB_SPIN_CAP (1u << 18)
__device__ __forceinline__ unsigned xb_ld(unsigned* p)              { return __hip_atomic_load(p, __ATOMIC_RELAXED, __HIP_MEMORY_SCOPE_AGENT); }
__device__ __forceinline__ unsigned xb_add(unsigned* p, unsigned v) { return __hip_atomic_fetch_add(p, v, __ATOMIC_RELAXED, __HIP_MEMORY_SCOPE_AGENT); }
__device__ __forceinline__ unsigned xb_xcc_id() { return (unsigned)__builtin_amdgcn_s_getreg((3 << 11) | 20) & 0xFu; }
#define XB_SPIN(cond, bar) do { unsigned _sp = 0; while (cond) { __builtin_amdgcn_s_sleep(1); \
    if ((++_sp & 255u) == 0u) { if (xb_ld(&(bar)[XB_TMO])) break; if (_sp > XB_SPIN_CAP) { atomicAdd(&(bar)[XB_TMO], 1u); break; } } } } while (0)
struct XcdBarrier { unsigned* bar; unsigned x; volatile LAS unsigned* st; };
__device__ __forceinline__ XcdBarrier xcd_barrier_post(unsigned* bar, volatile LAS unsigned* st) {
    XcdBarrier b; b.bar = bar; b.x = xb_xcc_id(); b.st = st;
    if (threadIdx.x == 0) (void)xb_add(&bar[XB_XCNT(b.x)], 1u);
    return b;
}
__device__ __forceinline__ void xcd_barrier_complete(unsigned* bar, unsigned x, unsigned& nloc, unsigned& nx) {
    const unsigned G = gridDim.x * gridDim.y * gridDim.z;
    unsigned sum, cnt, mine, sp = 0u;
    for (;;) {
        sum = 0u; cnt = 0u; mine = 0u;
#pragma unroll
        for (unsigned j = 0; j < 16; ++j) { const unsigned c = xb_ld(&bar[XB_XCNT(j)]); sum += c; cnt += (c > 0u) ? 1u : 0u; }
        mine = xb_ld(&bar[XB_XCNT(x)]);
        if (sum == G) break;
        __builtin_amdgcn_s_sleep(1);
        if ((++sp & 255u) == 0u) { if (xb_ld(&bar[XB_TMO])) break; if (sp > XB_SPIN_CAP) { atomicAdd(&bar[XB_TMO], 1u); break; } }
    }
    nloc = mine > 0u ? mine : 1u; nx = cnt > 0u ? cnt : 1u;
}
__device__ __forceinline__ void xcd_barrier(const XcdBarrier& b) {
    asm volatile("s_waitcnt vmcnt(0)" ::: "memory");
    __syncthreads();
    if (tidx() == 0) {
        unsigned* bar = b.bar; asm volatile("" : "+s"(bar));
        __builtin_amdgcn_s_waitcnt(0);
        unsigned nloc = b.st[0], nx = b.st[1];
        if (nloc == 0u) { xcd_barrier_complete(bar, b.x, nloc, nx); b.st[0] = nloc; b.st[1] = nx; }
        const unsigned old = xb_add(&bar[XB_XSUB(b.x)], 1u);
        const unsigned gen = old / nloc;
        __builtin_amdgcn_fence(__ATOMIC_ACQUIRE, "agent");
        if (old + 1u == (gen + 1u) * nloc) {
            __builtin_amdgcn_fence(__ATOMIC_RELEASE, "agent");
            asm volatile("s_waitcnt vmcnt(0)" ::: "memory");
            const unsigned og = xb_add(&bar[XB_TOP], 1u);
            const unsigned tg = og / nx;
            if (og + 1u == (tg + 1u) * nx) xb_add(&bar[XB_TOPGEN], 1u);
            else XB_SPIN(xb_ld(&bar[XB_TOPGEN]) == tg, bar);
            xb_add(&bar[XB_XGEN(b.x)], 1u);
            asm volatile("s_waitcnt vmcnt(0)" ::: "memory");
        } else {
            XB_SPIN(xb_ld(&bar[XB_XGEN(b.x)]) == gen, bar);
            asm volatile("s_waitcnt vmcnt(0)" ::: "memory");
        }
    }
    __syncthreads();
}

__device__ __forceinline__ void panel_sync(unsigned* ctl, int panel, volatile LAS unsigned* nsync) {
    asm volatile("s_waitcnt vmcnt(0)" ::: "memory");
    __syncthreads();
    if (tidx() == 64) { __builtin_amdgcn_fence(__ATOMIC_ACQUIRE, "agent"); asm volatile("s_waitcnt vmcnt(0)" ::: "memory"); }
    if (tidx() == 0) {
        unsigned* w = ctl + CW_PANEL + panel * 16; asm volatile("" : "+s"(w));
        unsigned* bar = ctl + CW_BAR;
        const unsigned target = 4u * (nsync[0] + 1u); nsync[0] = nsync[0] + 1u;
        (void)xb_add(w, 1u);
        XB_SPIN(xb_ld(w) < target, bar);
        asm volatile("s_waitcnt vmcnt(0)" ::: "memory");
    }
    __syncthreads();
}

__device__ __forceinline__ int rowblk(int bx) { const int m = bx >> 3, x = bx & 7; return (((m >> 2) * 8 + x) << 2) | (m & 3); }

constexpr int NWAVES = 8;
constexpr int RING_BYTES = 143360, LDSCTL_OFF = RING_BYTES, MISC_OFF = LDSCTL_OFF + 320, LDS_BYTES = 147456;
static_assert(att::L_END <= RING_BYTES && moba::L_END <= RING_BYTES && pg8::STAGE_BYTES <= RING_BYTES && WTAB_LDS == (unsigned)MISC_OFF + 128 && WTAB_LDS + 256 <= (unsigned)LDS_BYTES, "LDS map");

struct Args {
    const float* x; const float* c; const int* pos; const float* norm_g; const float* w_ada; const float* b_ada; const float* w_in;
    const float* q_norm_g; const float* w_uq; const float* kv_norm_g; const float* w_ukv; const float* q_g; const float* k_g;
    const float* mq_g; const float* mk_g; const float* w_out; const float* rel_bias;
    float* out; unsigned char* ws; int ph_lo, ph_hi;
};

__device__ __forceinline__ void transpose_item(const float* W, int K, int N, bf16_t* WT, int dstrow0, int k0, int n0, LAS float* scr, int lane) {
#pragma unroll 8
    for (int i = 0; i < 32; ++i) { const int kk = 2 * i + (lane >> 5); scr[kk * 33 + (lane & 31)] = W[(size_t)(k0 + kk) * N + n0 + (lane & 31)]; }
    LDS_WAIT(); asm volatile("" ::: "memory");
    const int c = lane & 7;
#pragma unroll
    for (int j = 0; j < 4; ++j) { const int n = (lane >> 3) + 8 * j; const LAS float* s = scr + (8 * c) * 33 + n;
        u32x4 o; o.x = pk2(s[0 * 33], s[1 * 33]); o.y = pk2(s[2 * 33], s[3 * 33]); o.z = pk2(s[4 * 33], s[5 * 33]); o.w = pk2(s[6 * 33], s[7 * 33]);
        *(u32x4*)(WT + (size_t)(dstrow0 + n) * K + k0 + 8 * c) = o; }
    LDS_WAIT(); asm volatile("" ::: "memory");
}

__global__ void __launch_bounds__(NWAVES * 64, 2) mk_fwd(Args A) {
    extern __shared__ __attribute__((aligned(16))) unsigned char lds_raw[];
    LAS unsigned char* lds = (LAS unsigned char*)lds_raw;
    volatile LAS unsigned* MISC = (volatile LAS unsigned*)(lds + MISC_OFF);
    const int tid = threadIdx.x, lane = tid & 63, wave = __builtin_amdgcn_readfirstlane(tid >> 6);
    const int G = gridDim.x, bx = blockIdx.x;
    const int vcu = (G % 8 == 0) ? (bx % 8) * (G / 8) + bx / 8 : bx;
    typedef __attribute__((address_space(4))) const Args* KArgsP;
    KArgsP kp0 = (KArgsP)__builtin_amdgcn_kernarg_segment_ptr();
    unsigned* ctl = (unsigned*)(A.ws + WS_CTL);
#define PH_ARGS KArgsP Ap = kp0; asm volatile("" : "+s"(Ap)); unsigned char* ws = Ap->ws; (void)ws; const int bx = launder_s32((int)blockIdx.x); (void)bx; \
    float* modb = (float*)(ws + WS_MOD); float* biasT = (float*)(ws + WS_BIAS); float* kpart = (float*)(ws + WS_KPART); float* ropeT = (float*)(ws + WS_ROPE); \
    bf16_t* Hb = (bf16_t*)(ws + WS_H); bf16_t* Zb = (bf16_t*)(ws + WS_Z); bf16_t* Qb = (bf16_t*)(ws + WS_Q); bf16_t* KVb = (bf16_t*)(ws + WS_KV); bf16_t* Kb = (bf16_t*)(ws + WS_K); \
    (void)modb; (void)biasT; (void)kpart; (void)ropeT; (void)Hb; (void)Zb; (void)Qb; (void)KVb; (void)Kb;
    for (int u = tid; u < (LDS_BYTES - LDSCTL_OFF) / 4; u += NWAVES * 64) ((LAS unsigned*)(lds + LDSCTL_OFF))[u] = 0u;
    __syncthreads();
    if ((threadIdx.x & 63) == 0) ((volatile LAS unsigned*)(size_t)WTAB_LDS)[hw_slot()] = threadIdx.x >> 6;
    __syncthreads();
    XcdBarrier bar; bar.bar = ctl + CW_BAR; bar.x = 0; bar.st = nullptr;
    if (MK_ONE_LAUNCH) bar = xcd_barrier_post(ctl + CW_BAR, MISC + 8);
    const int lo = A.ph_lo, hi_ = A.ph_hi;
#define IN(k) (lo <= (k) && (k) < hi_)
#define SEAM(k) do { if (IN(k) && IN((k) + 1)) xcd_barrier(bar); } while (0)
#define PSYNC(k) do { if (IN(k) && IN((k) + 1)) panel_sync(ctl, rowblk((int)blockIdx.x) >> 2, MISC + 20); } while (0)

    if (IN(0)) { PH_ARGS const int tid = launder(tidx()), lane = tid & 63, wave = __builtin_amdgcn_readfirstlane(tid >> 6); (void)tid; (void)lane; (void)wave;
        if (bx < 96) {
            const int l = bx / 48, n0 = (bx % 48) * 64;
            LAS float* sc = (LAS float*)lds;
            for (int i = tid; i < 2 * DMODEL; i += 512) { const float v = Ap->c[i]; sc[i] = v / (1.0f + __expf(-v)); }
            __syncthreads();
            float a0 = 0.f, a1 = 0.f; const float* wp = Ap->w_ada + ((size_t)l * DMODEL + wave * 128) * 3072 + n0 + lane;
#pragma unroll 1
            for (int k0 = 0; k0 < 128; k0 += 32) { float wv[32];
#pragma unroll
                for (int k = 0; k < 32; ++k) wv[k] = wp[(size_t)(k0 + k) * 3072];
#pragma unroll
                for (int k = 0; k < 32; ++k) { a0 += sc[wave * 128 + k0 + k] * wv[k]; a1 += sc[DMODEL + wave * 128 + k0 + k] * wv[k]; } }
            LAS float* red = (LAS float*)(lds + 8192);
            red[(wave * 2 + 0) * 64 + lane] = a0; red[(wave * 2 + 1) * 64 + lane] = a1;
            __syncthreads();
            if (wave == 0) { float s0 = 0.f, s1 = 0.f;
#pragma unroll
                for (int w = 0; w < 8; ++w) { s0 += red[(w * 2 + 0) * 64 + lane]; s1 += red[(w * 2 + 1) * 64 + lane]; }
                const float bb = Ap->b_ada[l * 3072 + n0 + lane];
                modb[(l * 2 + 0) * 3072 + n0 + lane] = s0 + bb; modb[(l * 2 + 1) * 3072 + n0 + lane] = s1 + bb; }
            __syncthreads();
        }
        {
            LAS float* scr = (LAS float*)(lds + wave * 16384);
            const int gw = bx * NWAVES + wave, NGW = G * NWAVES;
            constexpr int I_IN = 16 * 93, I_OUT = 16 * 32, I_L = I_IN + I_OUT;
            constexpr int NFAST = (256 - 96) * NWAVES, NBULK = 3 * NFAST;
            static_assert(DEPTH * I_L - NBULK <= 96 * NWAVES && DEPTH * I_L >= NBULK, "P0 item split");
            const bool fastwg = (G == 256) && bx >= 96;
            const int it0 = (G != 256) ? gw : (fastwg ? gw - 96 * NWAVES : NBULK + gw), itstep = (G != 256) ? NGW : (fastwg ? NFAST : DEPTH * I_L), itend = (G != 256 || !fastwg) ? DEPTH * I_L : NBULK;
            for (int it = it0; it < itend; it += itstep) {
                const int l = it / I_L; int r = it % I_L; unsigned char* wl = ws + WS_W + (size_t)l * W_LAYER;
                if (r < I_IN) { const int kb = r / 93, nb = r % 93; transpose_item(Ap->w_in + (size_t)l * DMODEL * D_IN, DMODEL, D_IN, (bf16_t*)(wl + W_IN), (nb >= 13 ? 96 : 0) + nb * 32, kb * 64, nb * 32, scr, lane); continue; } r -= I_IN;
                { const int kb = r / 32, nb = r % 32; transpose_item(Ap->w_out + (size_t)l * DMODEL * DMODEL, DMODEL, DMODEL, (bf16_t*)(wl + W_OUT), nb * 32, kb * 64, nb * 32, scr, lane); }
            }
        }
        {
            const int gt = bx * 512 + tid, NT_ = G * 512;
            for (int i = gt; i < DEPTH * 96 * 128; i += NT_) { const int l = i / (96 * 128), r = i % (96 * 128);
                *(u32x4*)(ws + WS_W + (size_t)l * W_LAYER + W_IN + (size_t)416 * 2048 + (size_t)r * 16) = (u32x4){0u, 0u, 0u, 0u}; }
            for (int i = gt; i < DEPTH * 40960; i += NT_) { const int l = i / 40960, r = i % 40960; unsigned char* wl = ws + WS_W + (size_t)l * W_LAYER;
                const float* W; int N, n, k0; unsigned char* dst;
                if (r < 24576) { const int ln = r & 63; int q = r >> 6; const int nb = q % 3; q /= 3; const int ks = q & 15, h = q >> 4;
                    n = 96 * h + 32 * nb + (ln & 31); k0 = 16 * ks + 8 * (ln >> 5); W = Ap->w_uq + (size_t)l * QLORA * NQ; N = NQ; dst = wl + W_UQ + (size_t)r * 16; }
                else { const int r2 = r - 24576, ln = r2 & 63, q = r2 >> 6, nb = q & 1, ks = (q >> 1) & 7, h = (q >> 4) & 7, isv = q >> 7;
                    n = 128 * h + 64 * isv + 32 * nb + (ln & 31); k0 = 16 * ks + 8 * (ln >> 5); W = Ap->w_ukv + (size_t)l * KVLORA * NKV; N = NKV; dst = wl + W_UKV + (size_t)r2 * 16; }
                float f[8];
#pragma unroll
                for (int j = 0; j < 8; ++j) f[j] = W[(size_t)(k0 + j) * N + n];
                u32x4 o; o.x = pk2(f[0], f[1]); o.y = pk2(f[2], f[3]); o.z = pk2(f[4], f[5]); o.w = pk2(f[6], f[7]);
                *(u32x4*)dst = o; }
            for (int i = gt; i < M * 16; i += NT_) { const int row = i >> 4, j = i & 15;
                const float invf = powf(10000.0f, -(float)j / 16.0f); const float ang = (float)Ap->pos[row] * invf;
                float sn, cs; sincosf(ang, &sn, &cs); ropeT[row * 32 + j] = cs; ropeT[row * 32 + 16 + j] = sn; }
            for (int i = gt; i < 8 * 8192; i += NT_) { const int h = i >> 13, d = i & 8191;
                int bk; if (d < 16) bk = d; else { bk = 8 + (31 - __clz(d * d)); if (bk > 31) bk = 31; }
                biasT[i] = Ap->rel_bias[bk * 8 + h] * LOG2E; }
        }
    }
    SEAM(0);

#pragma unroll 1
    for (int l = 0; l < DEPTH; ++l) {
        const int P = 1 + 5 * l;
#define WL (ws + WS_W + (size_t)l * W_LAYER)
#define XIN ((l == 0) ? Ap->x : Ap->out)
        if (IN(P)) { PH_ARGS const int tid = launder(tidx()), lane = tid & 63, wave = __builtin_amdgcn_readfirstlane(tid >> 6); (void)tid; (void)lane; (void)wave;
            const int gw = rowblk(bx) * NWAVES + wave; const int b = (gw * 8) / SEQ;
            const float* mv = modb + (l * 2 + b) * 3072;
            f32x4 ga[2][2], sh[2][2];
#pragma unroll
            for (int jj = 0; jj < 2; ++jj)
#pragma unroll
                for (int q = 0; q < 2; ++q) { const int c0 = 8 * lane + 512 * jj + 4 * q; const f32x4 g4 = *(const f32x4*)(Ap->norm_g + l * DMODEL + c0); const f32x4 s4 = *(const f32x4*)(mv + DMODEL + c0); ga[jj][q] = g4 * (s4 + 1.0f); sh[jj][q] = *(const f32x4*)(mv + c0); }
            { const int i0 = 0;
                f32x4 v[8][2][2]; float ss[8];
#pragma unroll
                for (int u = 0; u < 8; ++u) { const size_t row = (size_t)gw * 8 + i0 + u; ss[u] = 0.f;
#pragma unroll
                    for (int jj = 0; jj < 2; ++jj)
#pragma unroll
                        for (int q = 0; q < 2; ++q) { const f32x4 t = *(const f32x4*)(XIN + row * DMODEL + 8 * lane + 512 * jj + 4 * q); v[u][jj][q] = t; ss[u] += (t.x * t.x + t.y * t.y) + (t.z * t.z + t.w * t.w); } }
#pragma unroll
                for (int u = 0; u < 8; ++u) ss[u] = __builtin_amdgcn_rsqf(wave_sum(ss[u]) * (1.0f / DMODEL) + EPS);
#pragma unroll
                for (int u = 0; u < 8; ++u) { const size_t row = (size_t)gw * 8 + i0 + u;
#pragma unroll
                    for (int jj = 0; jj < 2; ++jj) { const f32x4 h0 = v[u][jj][0] * ss[u] * ga[jj][0] + sh[jj][0], h1 = v[u][jj][1] * ss[u] * ga[jj][1] + sh[jj][1];
                        u32x4 w; w.x = pk2(h0.x, h0.y); w.y = pk2(h0.z, h0.w); w.z = pk2(h1.x, h1.y); w.w = pk2(h1.z, h1.w);
                        store16_wt(Hb + row * DMODEL + 8 * lane + 512 * jj, w); } }
            }
        }
        PSYNC(P);
        if (IN(P + 1)) { PH_ARGS
            pg8::Gemm g{Hb, (const bf16_t*)(WL + W_IN), M, ZP, DMODEL, DMODEL, DMODEL}; pg8::PanelOrder S; S.init(rowblk(launder_s32(bx)), 3);
            pg8::EpiBf16 E{Zb, ZP};
            pg8::gemm_phase<pg8::EpiBf16, pg8::PanelOrder>(lds, g, S, E);
        }
        PSYNC(P + 1);
        if (IN(P + 2)) { PH_ARGS const int tid = launder(tidx()), lane = tid & 63, wave = __builtin_amdgcn_readfirstlane(tid >> 6); (void)tid; (void)lane; (void)wave;
            const int rbx = rowblk(bx);
            const int sub = lane & 7, r32 = lane & 31, hi = lane >> 5;
            constexpr int SROW = 1040;
            LAS unsigned char* stg = lds; LAS float* red = (LAS float*)(lds + 64 * SROW);
            constexpr int XQ_OFF = 64 * SROW + 16384, XQ_P = 528, XKV_OFF = XQ_OFF + 64 * XQ_P, XKV_P = 272, GQ_OFF = XKV_OFF + 64 * XKV_P, GK_OFF = GQ_OFF + 384, OST_W = 6656;
            static_assert(GK_OFF + 384 <= RING_BYTES && 8 * OST_W <= 64 * SROW, "phase C LDS map");
            if (tid < 96) { *(LAS float*)(lds + GQ_OFF + tid * 4) = Ap->q_g[l * 96 + tid]; *(LAS float*)(lds + GK_OFF + tid * 4) = Ap->k_g[l * 96 + tid]; }
            const int b = rbx / 128, s0 = (rbx % 128) * 64;
            bf16_t* KFb = (bf16_t*)(ws + WS_KF); bf16_t* VFb = (bf16_t*)(ws + WS_VF);
            u32x4 vrow[8];
#pragma unroll
            for (int i = 0; i < 8; ++i) vrow[i] = *(const u32x4*)(Zb + ((size_t)rbx * 64 + wave * 8 + i) * ZP + ZC_VB + 8 * lane);
            const f32x4 rope_pf = *(const f32x4*)(ropeT + ((size_t)rbx * 64 + (tid >> 3)) * 32 + (tid & 7) * 4);
            const u32x4 kr_pf = *(const u32x4*)(Zb + ((size_t)rbx * 64 + ((tid & 255) >> 2)) * ZP + ZC_KROPE + (tid & 3) * 8);
            constexpr int ROPE_L = 64 * SROW, ROPE_P = 144, KR_L = ROPE_L + 64 * ROPE_P, KR_P = 80;
            static_assert(KR_L + 64 * KR_P <= 64 * SROW + 16384, "rope / k_rope LDS tables");
            float kacc[8];
#pragma unroll
            for (int e = 0; e < 8; ++e) kacc[e] = 0.f;
            f32x4 qng = *(const f32x4*)(Ap->q_norm_g + l * QLORA + 4 * lane); f32x2 kng = *(const f32x2*)(Ap->kv_norm_g + l * KVLORA + 2 * lane);
            float mqg[8], mkg[8];
#pragma unroll
            for (int e = 0; e < 8; ++e) { mqg[e] = Ap->mq_g[l * 64 + 8 * sub + e] * QSCALE_B; mkg[e] = Ap->mk_g[l * 64 + 8 * sub + e]; }
            for (int i0 = 0; i0 < 8; i0 += 4) {
                u32x2 cw[4]; unsigned dw[4]; u32x4 qw[4], kw[4]; float rq[4], rk[4];
#pragma unroll
                for (int u = 0; u < 4; ++u) { const bf16_t* zr = Zb + ((size_t)rbx * 64 + wave * 8 + i0 + u) * ZP;
                    cw[u] = *(const u32x2*)(zr + ZC_CQ + 4 * lane); dw[u] = *(const unsigned*)(zr + ZC_CKV + 2 * lane); qw[u] = *(const u32x4*)(zr + ZC_QB + 8 * lane); kw[u] = *(const u32x4*)(zr + ZC_KB + 8 * lane); }
#pragma unroll
                for (int u = 0; u < 4; ++u) { const float a0 = bflo(cw[u].x), a1 = bfhi(cw[u].x), a2 = bflo(cw[u].y), a3 = bfhi(cw[u].y), c0 = bflo(dw[u]), c1 = bfhi(dw[u]);
                    rq[u] = (a0 * a0 + a1 * a1) + (a2 * a2 + a3 * a3); rk[u] = c0 * c0 + c1 * c1; }
#pragma unroll
                for (int u = 0; u < 4; ++u) { rq[u] = __builtin_amdgcn_rsqf(wave_sum(rq[u]) * (1.0f / QLORA) + EPS); rk[u] = __builtin_amdgcn_rsqf(wave_sum(rk[u]) * (1.0f / KVLORA) + EPS); }
#pragma unroll
                for (int u = 0; u < 4; ++u) { bf16_t* zr = Zb + ((size_t)rbx * 64 + wave * 8 + i0 + u) * ZP;
                    { const float v0 = bflo(cw[u].x), v1 = bfhi(cw[u].x), v2 = bflo(cw[u].y), v3 = bfhi(cw[u].y);
                      u32x2 o; o.x = pk2(v0 * rq[u] * qng.x, v1 * rq[u] * qng.y); o.y = pk2(v2 * rq[u] * qng.z, v3 * rq[u] * qng.w); *(LAS u32x2*)(lds + XQ_OFF + (wave * 8 + i0 + u) * XQ_P + lane * 8) = o; }
                    { const float v0 = bflo(dw[u]), v1 = bfhi(dw[u]); *(LAS unsigned*)(lds + XKV_OFF + (wave * 8 + i0 + u) * XKV_P + lane * 4) = pk2(v0 * rk[u] * kng.x, v1 * rk[u] * kng.y); }
                    { float v[8]; float ss = 0.f;
#pragma unroll
                      for (int e = 0; e < 4; ++e) { v[2 * e] = bflo(qw[u][e]); v[2 * e + 1] = bfhi(qw[u][e]); ss += v[2 * e] * v[2 * e] + v[2 * e + 1] * v[2 * e + 1]; }
                      const float rstd = __builtin_amdgcn_rsqf(sum8(ss) * (1.0f / 64.0f) + EPS); u32x4 o;
#pragma unroll
                      for (int e = 0; e < 4; ++e) o[e] = pk2(v[2 * e] * rstd * mqg[2 * e], v[2 * e + 1] * rstd * mqg[2 * e + 1]);
                      *(u32x4*)(zr + ZC_QB + 8 * lane) = o; }
                    { float v[8]; float ss = 0.f;
#pragma unroll
                      for (int e = 0; e < 4; ++e) { v[2 * e] = bflo(kw[u][e]); v[2 * e + 1] = bfhi(kw[u][e]); ss += v[2 * e] * v[2 * e] + v[2 * e + 1] * v[2 * e + 1]; }
                      const float rstd = __builtin_amdgcn_rsqf(sum8(ss) * (1.0f / 64.0f) + EPS); u32x4 o;
#pragma unroll
                      for (int e = 0; e < 8; ++e) { v[e] = v[e] * rstd * mkg[e]; kacc[e] += v[e]; }
#pragma unroll
                      for (int e = 0; e < 4; ++e) o[e] = pk2(v[2 * e], v[2 * e + 1]);
                      *(LAS u32x4*)(stg + (wave * 8 + i0 + u) * SROW + lane * 16) = o; }
                }
            }
#pragma unroll
            for (int e = 0; e < 8; ++e) red[wave * 512 + lane * 8 + e] = kacc[e];
            __syncthreads();
            { float sm = 0.f;
#pragma unroll
              for (int w = 0; w < 8; ++w) sm += red[w * 512 + tid];
              kpart[(size_t)rbx * 512 + tid] = sm; }
            { u32x4 kimg[8];
#pragma unroll
              for (int pi = 0; pi < 8; ++pi) { const int p = wave * 8 + pi, ktl = p >> 5, h = (p >> 2) & 7, d0 = p & 3;
                kimg[pi] = *(const LAS u32x4*)(stg + (32 * ktl + r32) * SROW + (h * 64 + d0 * 16 + hi * 8) * 2); }
              SBAR();
#pragma unroll
              for (int pi = 0; pi < 8; ++pi) { const int p = wave * 8 + pi, ktl = p >> 5, h = (p >> 2) & 7, d0 = p & 3;
                const int kt = s0 / 32 + ktl;
                store16_wt(KFb + ((((size_t)(b * 8 + h) * 256 + kt) * 4 + d0) * 64 + lane) * 8, kimg[pi]); } }
            __syncthreads();
#pragma unroll
            for (int i = 0; i < 8; ++i) *(LAS u32x4*)(stg + (wave * 8 + i) * SROW + lane * 16) = vrow[i];
            *(LAS f32x4*)(lds + ROPE_L + (tid >> 3) * ROPE_P + (tid & 7) * 16) = rope_pf;
            if (tid < 256) *(LAS u32x4*)(lds + KR_L + (tid >> 2) * KR_P + (tid & 3) * 16) = kr_pf;
            __syncthreads();
            { u32x4 vimg[8];
#pragma unroll
              for (int pi = 0; pi < 8; ++pi) { const int p = wave * 8 + pi, ksl = p >> 4, h = (p >> 1) & 7, dh = p & 1;
                const LAS unsigned char* cp = stg + (16 * ksl + 4 * hi) * SROW + (h * 64 + 32 * dh + r32) * 2;
                unsigned e[8];
#pragma unroll
                for (int j = 0; j < 8; ++j) e[j] = *(const LAS unsigned short*)(cp + ((j & 3) + 8 * (j >> 2)) * SROW);
                u32x4 w; w.x = e[0] | (e[1] << 16); w.y = e[2] | (e[3] << 16); w.z = e[4] | (e[5] << 16); w.w = e[6] | (e[7] << 16);
                vimg[pi] = w; }
              SBAR();
#pragma unroll
              for (int pi = 0; pi < 8; ++pi) { const int p = wave * 8 + pi, ksl = p >> 4, h = (p >> 1) & 7, dh = p & 1;
                const int ks = s0 / 16 + ksl;
                store16_wt(VFb + ((((size_t)(b * 8 + h) * 512 + ks) * 2 + dh) * 64 + lane) * 8, vimg[pi]); } }
            __syncthreads();
            {
                const int h = wave, row0 = rbx * 64;
                LAS unsigned char* ost = lds + wave * OST_W;
                const LAS unsigned char* xq = lds + XQ_OFF + r32 * XQ_P + hi * 16; const LAS unsigned char* xkv = lds + XKV_OFF + r32 * XKV_P + hi * 16;
                const LAS float* gqL = (const LAS float*)(lds + GQ_OFF); const LAS float* gkL = (const LAS float*)(lds + GK_OFF);
                const u32x4* wk = (const u32x4*)(WL + W_UKV) + (size_t)h * 1024 + lane; const u32x4* wv = (const u32x4*)(WL + W_UKV) + (size_t)(8 + h) * 1024 + lane;
                u32x4 ak[8][2], av[8][2];
                const LAS unsigned char* ropeL = lds + ROPE_L + r32 * ROPE_P; const LAS unsigned char* krL = lds + KR_L + r32 * KR_P;
                {
                    const u32x4* wq = (const u32x4*)(WL + W_UQ) + (size_t)h * 3072 + lane;
                    f32x16 acc[2][3];
#pragma unroll
                    for (int tb = 0; tb < 2; ++tb)
#pragma unroll
                        for (int nb = 0; nb < 3; ++nb) acc[tb][nb] = f32x16{};
                    u32x4 a[8][3];
#pragma unroll
                    for (int s_ = 0; s_ < 8; ++s_)
#pragma unroll
                        for (int nb = 0; nb < 3; ++nb) a[s_][nb] = wq[(s_ * 3 + nb) * 64];
                    SBAR();
#pragma unroll
                    for (int ks = 0; ks < 16; ++ks) {
                        bf16x8 bq[2];
#pragma unroll
                        for (int tb = 0; tb < 2; ++tb) bq[tb] = *(const LAS bf16x8*)(xq + tb * 32 * XQ_P + ks * 32);
#pragma unroll
                        for (int nb = 0; nb < 3; ++nb)
#pragma unroll
                            for (int tb = 0; tb < 2; ++tb) acc[tb][nb] = __builtin_amdgcn_mfma_f32_32x32x16_bf16(__builtin_bit_cast(bf16x8, a[ks & 7][nb]), bq[tb], acc[tb][nb], 0, 0, 0);
                        if (ks + 8 < 16) {
#pragma unroll
                            for (int nb = 0; nb < 3; ++nb) a[ks & 7][nb] = wq[((ks + 8) * 3 + nb) * 64]; }
                        SBAR();
                    }
#pragma unroll
                    for (int ks = 0; ks < 8; ++ks)
#pragma unroll
                        for (int nb = 0; nb < 2; ++nb) ak[ks][nb] = wk[(ks * 2 + nb) * 64];
                    SBAR();
#pragma unroll
                    for (int tb = 0; tb < 2; ++tb) {
                        const size_t row = (size_t)row0 + tb * 32 + r32;
                        float ss = 0.f;
#pragma unroll
                        for (int nb = 0; nb < 3; ++nb)
#pragma unroll
                            for (int r = 0; r < 16; ++r) ss += acc[tb][nb][r] * acc[tb][nb][r];
                        { auto rr = __builtin_amdgcn_permlane32_swap(__float_as_uint(ss), __float_as_uint(ss), false, false); ss = __uint_as_float(rr[0]) + __uint_as_float(rr[1]); }
                        const float rstd = QSCALE_A * __builtin_amdgcn_rsqf(ss * (1.0f / 96.0f) + EPS);
#pragma unroll
                        for (int nb = 0; nb < 2; ++nb)
#pragma unroll
                            for (int i = 0; i < 4; ++i) { const int n0 = nb * 32 + 8 * i + 4 * hi; const f32x4 g4 = *(const LAS f32x4*)(gqL + n0);
                                u32x2 o; o.x = pk2(acc[tb][nb][4 * i] * rstd * g4.x, acc[tb][nb][4 * i + 1] * rstd * g4.y); o.y = pk2(acc[tb][nb][4 * i + 2] * rstd * g4.z, acc[tb][nb][4 * i + 3] * rstd * g4.w);
                                *(LAS u32x2*)(ost + r32 * 208 + n0 * 2) = o; }
#pragma unroll
                        for (int i = 0; i < 2; ++i) { const int f0 = 8 * i + 4 * hi;
                            const f32x4 cs = *(const LAS f32x4*)(ropeL + tb * 32 * ROPE_P + f0 * 4), sn = *(const LAS f32x4*)(ropeL + tb * 32 * ROPE_P + 64 + f0 * 4);
                            const f32x4 g1 = *(const LAS f32x4*)(gqL + 64 + f0), g2 = *(const LAS f32x4*)(gqL + 80 + f0);
                            float o1[4], o2[4];
#pragma unroll
                            for (int j = 0; j < 4; ++j) { const float x1 = acc[tb][2][4 * i + j] * rstd * g1[j], x2 = acc[tb][2][4 * (i + 2) + j] * rstd * g2[j];
                                o1[j] = x1 * cs[j] - x2 * sn[j]; o2[j] = x1 * sn[j] + x2 * cs[j]; }
                            u32x2 w1, w2; w1.x = pk2(o1[0], o1[1]); w1.y = pk2(o1[2], o1[3]); w2.x = pk2(o2[0], o2[1]); w2.y = pk2(o2[2], o2[3]);
                            *(LAS u32x2*)(ost + r32 * 208 + (64 + f0) * 2) = w1; *(LAS u32x2*)(ost + r32 * 208 + (80 + f0) * 2) = w2; }
                        LDS_WAIT();
#pragma unroll
                        for (int k = 0; k < 6; ++k) { const int idx = lane + 64 * k, t = idx / 12, c = idx % 12;
                            const u32x4 v = *(const LAS u32x4*)(ost + t * 208 + c * 16);
                            *(u32x4*)(Qb + ((size_t)row0 + tb * 32 + t) * NQ + 96 * h + 8 * c) = v; }
                        LDS_WAIT();
                    }
                }
                {
                    f32x16 acc[2][2];
#pragma unroll
                    for (int tb = 0; tb < 2; ++tb)
#pragma unroll
                        for (int nb = 0; nb < 2; ++nb) acc[tb][nb] = f32x16{};
#pragma unroll
                    for (int ks = 0; ks < 8; ++ks) {
                        bf16x8 bq[2];
#pragma unroll
                        for (int tb = 0; tb < 2; ++tb) bq[tb] = *(const LAS bf16x8*)(xkv + tb * 32 * XKV_P + ks * 32);
#pragma unroll
                        for (int nb = 0; nb < 2; ++nb)
#pragma unroll
                            for (int tb = 0; tb < 2; ++tb) acc[tb][nb] = __builtin_amdgcn_mfma_f32_32x32x16_bf16(__builtin_bit_cast(bf16x8, ak[ks][nb]), bq[tb], acc[tb][nb], 0, 0, 0);
                    }
#pragma unroll
                    for (int ks = 0; ks < 8; ++ks)
#pragma unroll
                        for (int nb = 0; nb < 2; ++nb) av[ks][nb] = wv[(ks * 2 + nb) * 64];
                    SBAR();
#pragma unroll
                    for (int tb = 0; tb < 2; ++tb) {
                        const u32x4 kr1 = *(const LAS u32x4*)(krL + tb * 32 * KR_P + 16 * hi), kr2 = *(const LAS u32x4*)(krL + tb * 32 * KR_P + 32 + 16 * hi);
                        float x1[8], x2[8]; float ss = 0.f;
#pragma unroll
                        for (int e = 0; e < 4; ++e) { x1[2 * e] = bflo(kr1[e]); x1[2 * e + 1] = bfhi(kr1[e]); x2[2 * e] = bflo(kr2[e]); x2[2 * e + 1] = bfhi(kr2[e]); }
#pragma unroll
                        for (int e = 0; e < 8; ++e) ss += x1[e] * x1[e] + x2[e] * x2[e];
#pragma unroll
                        for (int nb = 0; nb < 2; ++nb)
#pragma unroll
                            for (int r = 0; r < 16; ++r) ss += acc[tb][nb][r] * acc[tb][nb][r];
                        { auto rr = __builtin_amdgcn_permlane32_swap(__float_as_uint(ss), __float_as_uint(ss), false, false); ss = __uint_as_float(rr[0]) + __uint_as_float(rr[1]); }
                        const float rstd = __builtin_amdgcn_rsqf(ss * (1.0f / 96.0f) + EPS);
#pragma unroll
                        for (int nb = 0; nb < 2; ++nb)
#pragma unroll
                            for (int i = 0; i < 4; ++i) { const int n0 = nb * 32 + 8 * i + 4 * hi; const f32x4 g4 = *(const LAS f32x4*)(gkL + n0);
                                u32x2 o; o.x = pk2(acc[tb][nb][4 * i] * rstd * g4.x, acc[tb][nb][4 * i + 1] * rstd * g4.y); o.y = pk2(acc[tb][nb][4 * i + 2] * rstd * g4.z, acc[tb][nb][4 * i + 3] * rstd * g4.w);
                                *(LAS u32x2*)(ost + r32 * 208 + n0 * 2) = o; }
                        { float o1[8], o2[8];
#pragma unroll
                          for (int q4 = 0; q4 < 2; ++q4) { const int f0 = 8 * hi + 4 * q4;
                              const f32x4 cs = *(const LAS f32x4*)(ropeL + tb * 32 * ROPE_P + f0 * 4), sn = *(const LAS f32x4*)(ropeL + tb * 32 * ROPE_P + 64 + f0 * 4);
                              const f32x4 g1 = *(const LAS f32x4*)(gkL + 64 + f0), g2 = *(const LAS f32x4*)(gkL + 80 + f0);
#pragma unroll
                              for (int j = 0; j < 4; ++j) { const float y1 = x1[4 * q4 + j] * rstd * g1[j], y2 = x2[4 * q4 + j] * rstd * g2[j];
                                  o1[4 * q4 + j] = y1 * cs[j] - y2 * sn[j]; o2[4 * q4 + j] = y1 * sn[j] + y2 * cs[j]; } }
                          u32x4 w1, w2;
#pragma unroll
                          for (int e = 0; e < 4; ++e) { w1[e] = pk2(o1[2 * e], o1[2 * e + 1]); w2[e] = pk2(o2[2 * e], o2[2 * e + 1]); }
                          *(LAS u32x4*)(ost + r32 * 208 + (64 + 8 * hi) * 2) = w1; *(LAS u32x4*)(ost + r32 * 208 + (80 + 8 * hi) * 2) = w2; }
                        LDS_WAIT();
#pragma unroll
                        for (int k = 0; k < 6; ++k) { const int idx = lane + 64 * k, t = idx / 12, c = idx % 12;
                            const u32x4 v = *(const LAS u32x4*)(ost + t * 208 + c * 16);
                            *(u32x4*)(Kb + ((size_t)row0 + tb * 32 + t) * NQ + 96 * h + 8 * c) = v; }
                        LDS_WAIT();
                    }
                }
                {
                    f32x16 acc[2][2];
#pragma unroll
                    for (int tb = 0; tb < 2; ++tb)
#pragma unroll
                        for (int nb = 0; nb < 2; ++nb) acc[tb][nb] = f32x16{};
#pragma unroll
                    for (int ks = 0; ks < 8; ++ks) {
                        bf16x8 bq[2];
#pragma unroll
                        for (int tb = 0; tb < 2; ++tb) bq[tb] = *(const LAS bf16x8*)(xkv + tb * 32 * XKV_P + ks * 32);
#pragma unroll
                        for (int nb = 0; nb < 2; ++nb)
#pragma unroll
                            for (int tb = 0; tb < 2; ++tb) acc[tb][nb] = __builtin_amdgcn_mfma_f32_32x32x16_bf16(__builtin_bit_cast(bf16x8, av[ks][nb]), bq[tb], acc[tb][nb], 0, 0, 0);
                    }
#pragma unroll
                    for (int tb = 0; tb < 2; ++tb) {
#pragma unroll
                        for (int nb = 0; nb < 2; ++nb)
#pragma unroll
                            for (int i = 0; i < 4; ++i) { const int n0 = nb * 32 + 8 * i + 4 * hi;
                                u32x2 o; o.x = pk2(acc[tb][nb][4 * i], acc[tb][nb][4 * i + 1]); o.y = pk2(acc[tb][nb][4 * i + 2], acc[tb][nb][4 * i + 3]);
                                *(LAS u32x2*)(ost + r32 * 144 + n0 * 2) = o; }
                        LDS_WAIT();
#pragma unroll
                        for (int k = 0; k < 4; ++k) { const int idx = lane + 64 * k, t = idx >> 3, c = idx & 7;
                            const u32x4 v = *(const LAS u32x4*)(ost + t * 144 + c * 16);
                            *(u32x4*)(KVb + ((size_t)row0 + tb * 32 + t) * NKV + 128 * h + 64 + 8 * c) = v; }
                        LDS_WAIT();
                    }
                }
            }
            __syncthreads();
        }
        SEAM(P + 2);
        if (IN(P + 3)) { PH_ARGS const int tid = launder(tidx()), lane = tid & 63; (void)lane;
            const int xg = bx & 7;
            unsigned* qctr = ctl + CW_Q + (l * 8 + xg) * 64;
            unsigned firstu = 0u; if (tidx() == 0) firstu = __hip_atomic_fetch_add(qctr, 1u, __ATOMIC_RELAXED, __HIP_MEMORY_SCOPE_AGENT);
            float gq = fabsf(Ap->mq_g[l * 64 + lane]), gk = fabsf(Ap->mk_g[l * 64 + lane]), bm = 0.f;
            float bm0 = fabsf(Ap->rel_bias[(lane & 31) * 8 + ((2 * xg) & 7)]), bm1 = fabsf(Ap->rel_bias[(lane & 31) * 8 + ((2 * xg + 1) & 7)]);
            gq = wave_max_nn(gq); gk = wave_max_nn(gk); bm0 = wave_max_nn(bm0); bm1 = wave_max_nn(bm1);
            const float gqk = 8.0f * gq * gk;
            if (tidx() == 0) MISC[16] = firstu;
            int done_panel = -1;
            for (;;) {
                __syncthreads();
                const unsigned ui = MISC[16];
                if (ui >= 128u) break;
                const int pslot = done_panel >= 0 ? l * 64 + done_panel : -1, fslot = (int)(CW_FDONE - CW_PCNT) / 16 + l;
                const int type = (int)(ui >> 6), r = (int)(ui & 63u), qb = 31 - (r >> 1), bh = 2 * xg + (r & 1), b = bh >> 3, h = bh & 7;
                done_panel = b * 32 + qb;
                if (type == 0) { att::Tens T{Qb + 96 * h, NQ, Kb + 96 * h, NQ, KVb + 128 * h + 64, NKV, Zb + ZC_GMLA + 64 * h, ZP, Zb + ZC_AO + 64 * h, ZP, 0.f};
                    att::unit<6>(T, b, qb, (LAS char*)lds, qctr, MISC + 16, ctl + CW_PCNT, pslot, fslot); }
                else {
                    bm = (r & 1) ? bm1 : bm0;
                    const float Bshift = fminf((gqk + bm) * LOG2E, 40.0f);
                    moba::Tens T{Zb + ZC_QB + 64 * h, ZP, Zb + ZC_GMOBA + 64 * h, ZP, Zb + ZC_AO + 512 + 64 * h, ZP, kpart, biasT + h * 8192, (const bf16_t*)(ws + WS_KF), (const bf16_t*)(ws + WS_VF), Bshift};
                    moba::unit(T, b, h, qb, (LAS char*)lds, qctr, MISC + 16, ctl + CW_PCNT, pslot, fslot); }
            }
            asm volatile("s_waitcnt vmcnt(0)" ::: "memory");
            __syncthreads();
            if (done_panel >= 0 && tidx() == 0) { (void)xb_add(ctl + CW_PCNT + (l * 64 + done_panel) * 16, 1u); (void)xb_add(ctl + CW_FDONE + l * 16, 1u); }
        }
        if (IN(P + 3) && IN(P + 4)) {
            asm volatile("s_waitcnt vmcnt(0)" ::: "memory");
            __syncthreads();
            if (tidx() == 64) { __builtin_amdgcn_fence(__ATOMIC_ACQUIRE, "agent"); asm volatile("s_waitcnt vmcnt(0)" ::: "memory"); }
            if (tidx() == 0) { unsigned* w = ctl + CW_PCNT + (l * 64 + (rowblk((int)blockIdx.x) >> 2)) * 16; unsigned* bar_ = ctl + CW_BAR;
                XB_SPIN(xb_ld(w) < 16u, bar_); asm volatile("s_waitcnt vmcnt(0)" ::: "memory"); }
            __syncthreads();
        }
        if (IN(P + 4)) { PH_ARGS
            pg8::Gemm g{Zb + ZC_AO, (const bf16_t*)(WL + W_OUT), M, DMODEL, DMODEL, ZP, DMODEL}; pg8::PanelOrder S; S.init(rowblk(launder_s32(bx)), 1);
            pg8::EpiResid E{XIN, Ap->out, DMODEL, modb + (l * 2) * 3072 + 2 * DMODEL, 3072};
            pg8::gemm_phase<pg8::EpiResid, pg8::PanelOrder>(lds, g, S, E);
        }
        if (l + 1 < DEPTH && IN(P + 4) && IN(P + 5)) {
            if (tidx() == 0) { unsigned* w = ctl + CW_FDONE + l * 16; unsigned* bar_ = ctl + CW_BAR; XB_SPIN(xb_ld(w) < 1024u, bar_); }
            panel_sync(ctl, rowblk((int)blockIdx.x) >> 2, MISC + 20);
        }
    }
#undef IN
#undef SEAM
}

constexpr int N_PHASES = 1 + 5 * DEPTH;

extern "C" void kernel_launch(void* const* d_in, const int* in_sizes, int n_in, void* d_out, int out_size, void* d_ws, size_t ws_size, hipStream_t stream) {
    static int ready = 0, one_launch = 0;
    if (ready == 0) {
        if (n_in != 17 || in_sizes[0] != M * DMODEL || out_size != M * DMODEL || ws_size < WS_END) { fprintf(stderr, "kernel_launch: unexpected shapes (n_in %d, in0 %d, out %d, ws %zu)\n", n_in, n_in > 0 ? in_sizes[0] : -1, out_size, ws_size); ready = -1; return; }
        if (hipFuncSetAttribute((const void*)mk_fwd, hipFuncAttributeMaxDynamicSharedMemorySize, LDS_BYTES) != hipSuccess) { fprintf(stderr, "kernel_launch: hipFuncSetAttribute failed\n"); ready = -1; return; }
        int dev = 0, cus = 0, per_cu = 0;
        if (hipGetDevice(&dev) != hipSuccess || hipDeviceGetAttribute(&cus, hipDeviceAttributeMultiprocessorCount, dev) != hipSuccess) cus = 0;
        if (hipOccupancyMaxActiveBlocksPerMultiprocessor(&per_cu, (const void*)mk_fwd, NWAVES * 64, LDS_BYTES) != hipSuccess) per_cu = 0;
        (void)hipGetLastError();
        one_launch = (MK_ONE_LAUNCH && (long)cus * (long)per_cu >= 256) ? 1 : 0;
        if (!one_launch) fprintf(stderr, "kernel_launch: %d CUs x %d resident workgroups < 256: falling back to one launch per phase\n", cus, per_cu);
        ready = 1;
    }
    if (ready < 0) return;
    (void)hipMemsetAsync((char*)d_ws + WS_CTL, 0, CTL_ZERO_BYTES, stream);
    Args a{};
    a.x = (const float*)d_in[0]; a.c = (const float*)d_in[1]; a.pos = (const int*)d_in[2]; a.norm_g = (const float*)d_in[3]; a.w_ada = (const float*)d_in[4]; a.b_ada = (const float*)d_in[5];
    a.w_in = (const float*)d_in[6]; a.q_norm_g = (const float*)d_in[7]; a.w_uq = (const float*)d_in[8]; a.kv_norm_g = (const float*)d_in[9]; a.w_ukv = (const float*)d_in[10];
    a.q_g = (const float*)d_in[11]; a.k_g = (const float*)d_in[12]; a.mq_g = (const float*)d_in[13]; a.mk_g = (const float*)d_in[14]; a.w_out = (const float*)d_in[15]; a.rel_bias = (const float*)d_in[16];
    a.out = (float*)d_out; a.ws = (unsigned char*)d_ws;
    const int grid = 256;
    if (one_launch) { a.ph_lo = 0; a.ph_hi = N_PHASES; hipLaunchKernelGGL(mk_fwd, dim3(grid), dim3(NWAVES * 64), LDS_BYTES, stream, a); }
    else for (int p = 0; p < N_PHASES; ++p) { a.ph_lo = p; a.ph_hi = p + 1; hipLaunchKernelGGL(mk_fwd, dim3(grid), dim3(NWAVES * 64), LDS_BYTES, stream, a); }
}
```
